# Optimizing an MI355X kernel written in HIP

```python
import jax, jax.numpy as jnp
from jax import lax
import numpy as np

D_MODEL = 1024
BATCH = 8
SEQ = 2048
DEPTH = 1

GRID_W = 64
CTX_LEN = 256
CONV_W = 512
CONV_K = 3
N_HEADS = 8
N_KV_HEADS = 2
HEAD_DIM = 64
ATT_W = N_HEADS * HEAD_DIM
KV_W = N_KV_HEADS * HEAD_DIM
WINDOW = 128
BLOCK = 128
ROPE_BASE = 10000.0
N_GROUPS = 4
EXPERTS_PER_GROUP = 8
N_EXPERTS = N_GROUPS * EXPERTS_PER_GROUP
TOP_K = 2
EXPERT_FF = 256
N_MOD = 6
NORM_EPS = 1e-6
NEG_INF = -1e30
IN_SIZES = (CONV_W, CONV_W, CONV_W, ATT_W, KV_W, KV_W, D_MODEL, D_MODEL)
IN_COLS = sum(IN_SIZES)
KV_OFF = 3 * CONV_W + ATT_W

kernel_name = 'hybrid_shortconv_swa_hmoe_dit_block'


def rmsnorm(x, g):
    xf = x.astype(jnp.float32)
    inv = lax.rsqrt(jnp.mean(xf * xf, axis=-1, keepdims=True) + NORM_EPS)
    return (xf * inv).astype(x.dtype) * g


def modulate(h, shift, scale):
    return h * (1 + scale) + shift


def split_in(u):
    idx = np.cumsum(IN_SIZES)[:-1].tolist()
    return jnp.split(u, idx, axis=-1)


def axial_rope(rows):
    n_freq = HEAD_DIM // 4
    inv_freq = ROPE_BASE ** (-jnp.arange(n_freq, dtype=jnp.float32) / n_freq)
    row = jnp.repeat(jnp.arange(rows, dtype=jnp.float32), GRID_W)
    col = jnp.tile(jnp.arange(GRID_W, dtype=jnp.float32), rows)
    ang = jnp.concatenate([row[:, None] * inv_freq, col[:, None] * inv_freq], axis=-1)
    return jnp.cos(ang), jnp.sin(ang)


def apply_rope(t, cos, sin):
    half = HEAD_DIM // 2
    c = cos[:, None, :].astype(t.dtype)
    s = sin[:, None, :].astype(t.dtype)
    t1, t2 = t[..., :half], t[..., half:]
    return jnp.concatenate([t1 * c - t2 * s, t1 * s + t2 * c], axis=-1)


def short_conv_branch(b, cg, xin, w_conv, b_conv, w_a):
    u = cg * xin
    L = u.shape[1]
    pad = CONV_K // 2
    up = jnp.pad(u, ((0, 0), (pad, pad), (0, 0)))
    y = b_conv + sum(up[:, j:j + L] * w_conv[j] for j in range(CONV_K))
    return (b * y) @ w_a


def window_attention(q, k, v, k_ctx, v_ctx, sink):
    B, L = q.shape[:2]
    C = k_ctx.shape[1]
    nb = L // BLOCK
    G = N_HEADS // N_KV_HEADS
    scale = HEAD_DIM ** -0.5
    qb = q.reshape(B, nb, BLOCK, N_KV_HEADS, G, HEAD_DIM)

    def band(t):
        tp = jnp.pad(t, ((0, 0), (BLOCK, BLOCK), (0, 0), (0, 0)))
        tp = tp.reshape(B, nb + 2, BLOCK, N_KV_HEADS, HEAD_DIM)
        return jnp.concatenate([tp[:, :-2], tp[:, 1:-1], tp[:, 2:]], axis=2)

    kw, vw = band(k), band(v)
    s_win = jnp.einsum('bnqkgd,bnjkd->bnkgqj', qb, kw).astype(jnp.float32) * scale
    s_ctx = jnp.einsum('bnqkgd,bckd->bnkgqc', qb, k_ctx).astype(jnp.float32) * scale
    blk = jnp.arange(nb)[:, None, None] * BLOCK
    qpos = blk + jnp.arange(BLOCK)[None, :, None]
    kpos = blk - BLOCK + jnp.arange(3 * BLOCK)[None, None, :]
    valid = (jnp.abs(qpos - kpos) <= WINDOW) & (kpos >= 0) & (kpos < L)
    s_win = jnp.where(valid[None, :, None, None], s_win, NEG_INF)
    s_sink = jnp.broadcast_to(sink.astype(jnp.float32).reshape(N_KV_HEADS, G, 1, 1), s_win.shape[:-1] + (1,))
    p = jax.nn.softmax(jnp.concatenate([s_win, s_ctx, s_sink], axis=-1), axis=-1).astype(v.dtype)
    w3 = 3 * BLOCK
    o = (jnp.einsum('bnkgqj,bnjkd->bnqkgd', p[..., :w3], vw)
         + jnp.einsum('bnkgqc,bckd->bnqkgd', p[..., w3:w3 + C], v_ctx))
    return o.reshape(B, L, ATT_W)


def context_attention(q, k, v, sink):
    B, C = q.shape[:2]
    G = N_HEADS // N_KV_HEADS
    qg = q.reshape(B, C, N_KV_HEADS, G, HEAD_DIM)
    s = jnp.einsum('bqkgd,bckd->bkgqc', qg, k).astype(jnp.float32) * HEAD_DIM ** -0.5
    s_sink = jnp.broadcast_to(sink.astype(jnp.float32).reshape(N_KV_HEADS, G, 1, 1), s.shape[:-1] + (1,))
    p = jax.nn.softmax(jnp.concatenate([s, s_sink], axis=-1), axis=-1).astype(v.dtype)
    o = jnp.einsum('bkgqc,bckd->bqkgd', p[..., :C], v)
    return o.reshape(B, C, ATT_W)


def context_kv(hc, w_in):
    B, C = hc.shape[:2]
    k = (hc @ w_in[:, KV_OFF:KV_OFF + KV_W]).reshape(B, C, N_KV_HEADS, HEAD_DIM)
    v = (hc @ w_in[:, KV_OFF + KV_W:KV_OFF + 2 * KV_W]).reshape(B, C, N_KV_HEADS, HEAD_DIM)
    return k, v


def token_mixer_context(hc, w_in, w_conv, b_conv, w_a, w_b, sink, w_o):
    B, C = hc.shape[:2]
    b, cg, xin, q, k, v, ga, gb = split_in(hc @ w_in)
    k = k.reshape(B, C, N_KV_HEADS, HEAD_DIM)
    v = v.reshape(B, C, N_KV_HEADS, HEAD_DIM)
    ya = short_conv_branch(b, cg, xin, w_conv, b_conv, w_a)
    yb = context_attention(q.reshape(B, C, N_HEADS, HEAD_DIM), k, v, sink) @ w_b
    y = (jax.nn.sigmoid(ga) * ya + jax.nn.sigmoid(gb) * yb) @ w_o
    return y, k, v


def token_mixer_latent(h, k_ctx, v_ctx, cos, sin, w_in, w_conv, b_conv, w_a, w_b, sink, w_o):
    B, L = h.shape[:2]
    b, cg, xin, q, k, v, ga, gb = split_in(h @ w_in)
    ya = short_conv_branch(b, cg, xin, w_conv, b_conv, w_a)
    q = apply_rope(q.reshape(B, L, N_HEADS, HEAD_DIM), cos, sin)
    k = apply_rope(k.reshape(B, L, N_KV_HEADS, HEAD_DIM), cos, sin)
    v = v.reshape(B, L, N_KV_HEADS, HEAD_DIM)
    yb = window_attention(q, k, v, k_ctx, v_ctx, sink) @ w_b
    return (jax.nn.sigmoid(ga) * ya + jax.nn.sigmoid(gb) * yb) @ w_o


def hierarchical_moe(h, w_group, b_group, w_router, b_router, w_up, w_down):
    shp = h.shape
    t = h.reshape(-1, shp[-1])
    n = t.shape[0]
    g_prob = jax.nn.softmax((t @ w_group + b_group).astype(jnp.float32), axis=-1)
    p_g, g_idx = lax.top_k(g_prob, 1)
    e_logits = (t @ w_router + b_router).astype(jnp.float32).reshape(n, N_GROUPS, EXPERTS_PER_GROUP)
    e_sel = jnp.take_along_axis(e_logits, g_idx[:, :, None], axis=1)[:, 0]
    top_p, top_i = lax.top_k(jax.nn.softmax(e_sel, axis=-1), TOP_K)
    gate = p_g * top_p / jnp.sum(top_p, axis=-1, keepdims=True)
    ids = g_idx * EXPERTS_PER_GROUP + top_i
    combine = jnp.sum(jax.nn.one_hot(ids, N_EXPERTS, dtype=jnp.float32) * gate[..., None], axis=1).astype(t.dtype)
    y = jnp.zeros_like(t)
    for e in range(N_EXPERTS):
        a, u = jnp.split(t @ w_up[e], 2, axis=-1)
        y = y + combine[:, e:e + 1] * ((jax.nn.silu(a) * u) @ w_down[e])
    return y.reshape(shp)


def setup_inputs(seed: int = 0) -> dict:
    key = jax.random.key(seed)
    ks = jax.random.split(key, 24)
    f32 = jnp.float32
    D = D_MODEL

    def nrm(k, shape, scale):
        return jax.random.normal(k, shape, f32) * scale

    return {
        'x': nrm(ks[0], (BATCH, SEQ, D), 1.0),
        'c': nrm(ks[1], (BATCH, D), 1.0),
        'ctx': nrm(ks[2], (BATCH, CTX_LEN, D), 1.0),
        'c_ctx': nrm(ks[3], (D,), 1.0),
        'w_ada': nrm(ks[4], (DEPTH, D, N_MOD * D), 0.5 * D ** -0.5),
        'b_ada': nrm(ks[5], (DEPTH, N_MOD * D), 0.02),
        'norm1_g': 1.0 + nrm(ks[6], (DEPTH, D), 0.01),
        'w_in': nrm(ks[7], (DEPTH, D, IN_COLS), D ** -0.5),
        'w_conv': nrm(ks[8], (DEPTH, CONV_K, CONV_W), CONV_K ** -0.5),
        'b_conv': nrm(ks[9], (DEPTH, CONV_W), 0.02),
        'w_a': nrm(ks[10], (DEPTH, CONV_W, D), CONV_W ** -0.5),
        'w_b': nrm(ks[11], (DEPTH, ATT_W, D), ATT_W ** -0.5),
        'sink': nrm(ks[12], (DEPTH, N_HEADS), 0.5),
        'w_o': nrm(ks[13], (DEPTH, D, D), D ** -0.5),
        'norm2_g': 1.0 + nrm(ks[14], (DEPTH, D), 0.01),
        'w_group': nrm(ks[15], (DEPTH, D, N_GROUPS), D ** -0.5),
        'b_group': nrm(ks[16], (DEPTH, N_GROUPS), 0.01),
        'w_router': nrm(ks[17], (DEPTH, D, N_EXPERTS), D ** -0.5),
        'b_router': nrm(ks[18], (DEPTH, N_EXPERTS), 0.01),
        'w_up': nrm(ks[19], (DEPTH, N_EXPERTS, D, 2 * EXPERT_FF), D ** -0.5),
        'w_down': nrm(ks[20], (DEPTH, N_EXPERTS, EXPERT_FF, D), EXPERT_FF ** -0.5),
        'final_g': 1.0 + nrm(ks[21], (D,), 0.01),
    }


def reference(x, c, ctx, c_ctx, w_ada, b_ada, norm1_g, w_in, w_conv, b_conv, w_a, w_b, sink, w_o,
              norm2_g, w_group, b_group, w_router, b_router, w_up, w_down, final_g):
    L = x.shape[1]
    rows = L // GRID_W
    cos, sin = axial_rope(rows)
    xc = ctx
    for l in range(DEPTH):
        last = l == DEPTH - 1
        mod = (jax.nn.silu(c) @ w_ada[l] + b_ada[l])[:, None, :]
        sh1, sc1, g1, sh2, sc2, g2 = jnp.split(mod, N_MOD, axis=-1)
        modc = jax.nn.silu(c_ctx) @ w_ada[l] + b_ada[l]
        csh1, csc1, cg1, csh2, csc2, cg2 = jnp.split(modc, N_MOD, axis=-1)

        hc = modulate(rmsnorm(xc, norm1_g[l]), csh1, csc1)
        if last:
            k_ctx, v_ctx = context_kv(hc, w_in[l])
        else:
            yc, k_ctx, v_ctx = token_mixer_context(hc, w_in[l], w_conv[l], b_conv[l], w_a[l], w_b[l], sink[l], w_o[l])
            xc = xc + cg1 * yc
        h = modulate(rmsnorm(x, norm1_g[l]), sh1, sc1)
        x = x + g1 * token_mixer_latent(h, k_ctx, v_ctx, cos, sin, w_in[l], w_conv[l], b_conv[l],
                                        w_a[l], w_b[l], sink[l], w_o[l])

        h = modulate(rmsnorm(x, norm2_g[l]), sh2, sc2)
        x = x + g2 * hierarchical_moe(h, w_group[l], b_group[l], w_router[l], b_router[l], w_up[l], w_down[l])
        if not last:
            hc = modulate(rmsnorm(xc, norm2_g[l]), csh2, csc2)
            xc = xc + cg2 * hierarchical_moe(hc, w_group[l], b_group[l], w_router[l], b_router[l], w_up[l], w_down[l])
    return rmsnorm(x, final_g)
```

```cpp
#include <hip/hip_runtime.h>
#include <hip/hip_cooperative_groups.h>
#include <cstdio>
#include <cstdint>
namespace cg = cooperative_groups;

#ifndef MK_N_LAUNCHES
#define MK_N_LAUNCHES 1
#endif

#define LAS __attribute__((address_space(3)))
#define GAS __attribute__((address_space(1)))
typedef unsigned short bf16_t;
typedef short bf16x8 __attribute__((ext_vector_type(8)));
typedef short s16x4 __attribute__((ext_vector_type(4)));
typedef float f32x2 __attribute__((ext_vector_type(2)));
typedef float f32x4 __attribute__((ext_vector_type(4)));
typedef float f32x16 __attribute__((ext_vector_type(16)));
typedef unsigned u32x2 __attribute__((ext_vector_type(2)));
typedef unsigned u32x4 __attribute__((ext_vector_type(4)));
typedef int i32x2 __attribute__((ext_vector_type(2)));

constexpr int DM = 1024, NBATCH = 8, SEQ = 2048, MLAT = NBATCH * SEQ, CTXL = 256, MCTX = NBATCH * CTXL, MALL = MLAT + MCTX;
constexpr int NIN = 4352;
constexpr int C_B = 0, C_CG = 512, C_X = 1024, C_Q = 1536, C_K = 2048, C_V = 2176, C_GA = 2304, C_GB = 3328;
constexpr int NEXP = 32, EFF = 256, LISTCAP = 16384;
constexpr float NORM_EPS = 1e-6f;
constexpr float QSCALE = 0.125f * 1.4426950408889634f;
constexpr float LOG2E = 1.4426950408889634f;
constexpr int NPHASE = 10;

constexpr size_t MiB = 1u << 20;
constexpr size_t WS_CTL = 0, CTL_ZERO_BYTES = 1 * MiB;
constexpr size_t WS_MOD = 1 * MiB;
constexpr size_t WS_ROPE = 1 * MiB + 512 * 1024;
constexpr size_t WS_WR = 2 * MiB;
constexpr size_t WS_LIST = 3 * MiB;
constexpr size_t WS_WIN = 7 * MiB;
constexpr size_t WS_WA = 16 * MiB, WS_WB = 17 * MiB, WS_WO = 18 * MiB;
constexpr size_t WS_WUP = 20 * MiB;
constexpr size_t WS_WDN = 52 * MiB;
constexpr size_t WS_KVC = 68 * MiB;
constexpr size_t WS_Z = 70 * MiB;
constexpr size_t WS_U = 102 * MiB;
constexpr size_t WS_H2 = 102 * MiB, WS_Y0 = 134 * MiB, WS_Y1 = 166 * MiB, WS_ACT = 198 * MiB;
constexpr size_t WS_DUMP = 238 * MiB;
constexpr size_t WS_END = 239 * MiB;
constexpr size_t DO_H = 0, DO_A1 = 0, DO_O = 16 * MiB;
constexpr int CW_CNT = 1024;
constexpr int CW_BAR = 4096;

constexpr int RING_BYTES = 131072;
constexpr int MISC_OFF = RING_BYTES;
constexpr int LDS_BYTES = 147456;

#define LDS_WAIT() asm volatile("s_waitcnt lgkmcnt(0)" ::: "memory")
#define VM_WAIT() asm volatile("s_waitcnt vmcnt(0)" ::: "memory")

__device__ __forceinline__ unsigned f2bf(float f) { unsigned u = __builtin_bit_cast(unsigned, f); return (u + 0x7fffu + ((u >> 16) & 1u)) >> 16; }
__device__ __forceinline__ unsigned pk2(float lo, float hi) { return f2bf(lo) | (f2bf(hi) << 16); }
__device__ __forceinline__ float bf2f(unsigned short h) { return __builtin_bit_cast(float, (unsigned)h << 16); }
__device__ __forceinline__ float bflo(unsigned w) { return __builtin_bit_cast(float, w << 16); }
__device__ __forceinline__ float bfhi(unsigned w) { return __builtin_bit_cast(float, w & 0xffff0000u); }
__device__ __forceinline__ unsigned cvt_pk_bf16(float lo, float hi) { unsigned r; asm volatile("v_cvt_pk_bf16_f32 %0, %1, %2" : "=v"(r) : "v"(lo), "v"(hi)); return r; }
__device__ __forceinline__ float wave_sum(float v) {
#pragma unroll
    for (int o = 1; o < 64; o <<= 1) v += __shfl_xor(v, o);
    return v;
}
__device__ __forceinline__ float sigmoidf_(float g) { g = fminf(fmaxf(g, -30.f), 30.f); return 1.0f / (1.0f + __expf(-g)); }

namespace pg8 {
constexpr int BM = 256, BK = 64, HALF = 128, HTB = HALF * BK * 2, STAGE_BYTES = 8 * HTB, NXCD = 8, WGM = 8;
__host__ __device__ __forceinline__ int lds_byte(int r, int c) { const int st = (r >> 4) * 2 + (c >> 5), rr = r & 15, cc = c & 31, ob = rr * 64 + cc * 2; return st * 1024 + (ob ^ (((ob >> 9) & 1) << 5)); }
__host__ __device__ __forceinline__ void stage_rc(int b, int& R, int& C) { const int st = b / 1024, sb = b % 1024, swz = sb ^ (((sb >> 9) & 1) << 5); R = (st >> 1) * 16 + swz / 64; C = (st & 1) * 32 + (swz % 64) / 2; }
__host__ __device__ __forceinline__ int perm32(int rho) { const int n = rho >> 4, i = rho & 15; return 8 * (i >> 2) + 4 * n + (i & 3); }

struct Unit { int pm, pn, aux; };
__device__ __forceinline__ void static_map(int nM, int nN, int L, int& pm, int& pn) {
    const int nwg = nM * nN; int wgid = L;
    { const int q = nwg / NXCD, r = nwg % NXCD, xcd = wgid % NXCD, off = wgid / NXCD; wgid = (xcd < r ? xcd * (q + 1) : r * (q + 1) + (xcd - r) * q) + off; }
    const int nig = WGM * nN, gid = wgid / nig, fm = gid * WGM, gsz = (nM - fm) < WGM ? (nM - fm) : WGM;
    pm = fm + ((wgid % nig) % gsz); pn = (wgid % nig) / gsz;
}
typedef f32x4 Acc[2][2][4][2];

template <class Epi, class Sched, bool ALIGN_EPI, bool GATHER>
__device__ __forceinline__ void gemm_phase(LAS unsigned char* lds, const int K, const Sched& S, const Epi& E) {
    const int tid = threadIdx.x, wid = __builtin_amdgcn_readfirstlane(tid >> 6), lane = tid & 63, wr = wid >> 2, wc = wid & 3, fr = lane & 15, fq = lane >> 4;
    const int nt = K / BK;
    int stR[2], stC[2];
    unsigned voffB[2], vA0[2], vA1[2], nA0[2], nA1[2];
    const size_t kstep = (size_t)(BK * 2);
    const size_t hstep = (size_t)HALF * K * 2;
#pragma unroll
    for (int i = 0; i < 2; ++i) { int R, C; stage_rc(tid * 16 + i * 8192, R, C); const int Rb = Epi::PERM ? ((R & ~31) + perm32(R & 31)) : R;
        stR[i] = R; stC[i] = C; voffB[i] = (unsigned)(Rb * K + C) * 2u; vA0[i] = (unsigned)(R * K + C) * 2u; vA1[i] = vA0[i] + (unsigned)hstep; nA0[i] = vA0[i]; nA1[i] = vA1[i]; }
    const unsigned ldsw = (unsigned)wid * 1024u;
    const int aoff = lds_byte(wr * 64 + fr, fq * 8), boff = lds_byte(wc * 32 + fr, fq * 8);
#define PG8_SA(b, h) (((b) * 2 + (h)) * HTB)
#define PG8_SB(b, h) ((4 + (b) * 2 + (h)) * HTB)
#define PG8_STAGE(bufoff, gbase, voff) do { _Pragma("unroll") for (int _i = 0; _i < 2; ++_i) \
        __builtin_amdgcn_global_load_lds((const unsigned*)((const char*)(gbase) + (voff)[_i]), (LAS unsigned*)(lds + (bufoff) + ldsw + _i * 8192), 16, 0, 0); } while (0)
#define PG8_LDA(dst, b, h) do { _Pragma("unroll") for (int m = 0; m < 4; ++m) _Pragma("unroll") for (int k = 0; k < 2; ++k) dst[m][k] = *(const LAS bf16x8*)(lds + PG8_SA(b, h) + aoff + m * 2048 + k * 1024); } while (0)
#define PG8_LDB(dst, b, h) do { _Pragma("unroll") for (int n = 0; n < 2; ++n) _Pragma("unroll") for (int k = 0; k < 2; ++k) dst[n][k] = *(const LAS bf16x8*)(lds + PG8_SB(b, h) + boff + n * 2048 + k * 1024); } while (0)
#define PG8_MMA(ai, bj, At, Bt) do { __builtin_amdgcn_s_setprio(1); _Pragma("unroll") for (int m = 0; m < 4; ++m) _Pragma("unroll") for (int n = 0; n < 2; ++n) _Pragma("unroll") for (int k = 0; k < 2; ++k) \
        acc[ai][bj][m][n] = __builtin_amdgcn_mfma_f32_16x16x32_bf16(Bt[n][k], At[m][k], acc[ai][bj][m][n], 0, 0, 0); __builtin_amdgcn_s_setprio(0); } while (0)
#define PG8_WAIT_V(n) asm volatile("s_waitcnt vmcnt(" #n ")" ::: "memory")
#define PG8_WAIT_L(n) asm volatile("s_waitcnt lgkmcnt(" #n ")" ::: "memory")
#define PG8_BAR __builtin_amdgcn_s_barrier()
#define PG8_SCHED __builtin_amdgcn_sched_barrier(0)
    Unit cur, nxt; int ui = 0;
    if (!S.next(0, cur)) return;
    Acc acc;
#pragma unroll
    for (int a = 0; a < 2; ++a)
#pragma unroll
        for (int b = 0; b < 2; ++b)
#pragma unroll
            for (int m = 0; m < 4; ++m)
#pragma unroll
                for (int n = 0; n < 2; ++n) acc[a][b][m][n] = (f32x4){0.f, 0.f, 0.f, 0.f};
    bf16x8 At[4][2], B0[2][2], B1[2][2];
    const char* cA = S.abase(cur); const char* cB = S.bbase(cur);
    if constexpr (GATHER) {
#pragma unroll
        for (int i = 0; i < 2; ++i) { vA0[i] = (unsigned)(S.arow(cur, stR[i]) * K + stC[i]) * 2u; vA1[i] = (unsigned)(S.arow(cur, HALF + stR[i]) * K + stC[i]) * 2u; }
    }
    PG8_STAGE(PG8_SB(0, 0), cB, voffB); PG8_STAGE(PG8_SB(0, 1), cB + hstep, voffB); PG8_STAGE(PG8_SA(0, 0), cA, vA0); PG8_STAGE(PG8_SA(0, 1), cA, vA1);
    if (wr == 1) PG8_BAR;
    PG8_WAIT_V(2); PG8_BAR;
    PG8_STAGE(PG8_SB(1, 0), cB + kstep, voffB); PG8_STAGE(PG8_SA(1, 0), cA + kstep, vA0); PG8_STAGE(PG8_SB(1, 1), cB + hstep + kstep, voffB);
    PG8_WAIT_V(6); PG8_BAR;
    for (;;) {
        const bool has_next = S.next(ui + 1, nxt);
        const char* nA = has_next ? S.abase(nxt) : cA; const char* nB = has_next ? S.bbase(nxt) : cB;
        if constexpr (GATHER) {
            if (has_next) {
#pragma unroll
                for (int i = 0; i < 2; ++i) { nA0[i] = (unsigned)(S.arow(nxt, stR[i]) * K + stC[i]) * 2u; nA1[i] = (unsigned)(S.arow(nxt, HALF + stR[i]) * K + stC[i]) * 2u; }
            } else {
#pragma unroll
                for (int i = 0; i < 2; ++i) { nA0[i] = vA0[i]; nA1[i] = vA1[i]; }
            }
        }
#pragma unroll 1
        for (int t = 0; t < nt; t += 2) {
            const bool last = (t == nt - 2);
            const char* a1 = cA + (size_t)(t + 1) * kstep;
            const char* a2 = last ? nA : cA + (size_t)(t + 2) * kstep; const char* b2 = last ? nB : cB + (size_t)(t + 2) * kstep;
            const char* a3 = a2 + kstep; const char* b3 = b2 + kstep;
            unsigned xA0[2], xA1[2];
#pragma unroll
            for (int i = 0; i < 2; ++i) { xA0[i] = (GATHER && last) ? nA0[i] : vA0[i]; xA1[i] = (GATHER && last) ? nA1[i] : vA1[i]; }
            PG8_LDB(B0, 0, 0); PG8_LDB(B1, 0, 1); PG8_SCHED; PG8_LDA(At, 0, 0); PG8_STAGE(PG8_SA(1, 1), a1, vA1);
            PG8_WAIT_V(8); PG8_WAIT_L(0); PG8_BAR; PG8_MMA(0, 0, At, B0); PG8_MMA(0, 1, At, B1); PG8_BAR; PG8_SCHED;
            PG8_LDA(At, 0, 1); PG8_STAGE(PG8_SB(0, 0), b2, voffB); PG8_STAGE(PG8_SB(0, 1), b2 + hstep, voffB); PG8_STAGE(PG8_SA(0, 0), a2, xA0);
            PG8_WAIT_V(8); PG8_WAIT_L(0); PG8_BAR; PG8_MMA(1, 0, At, B0); PG8_MMA(1, 1, At, B1); PG8_BAR; PG8_SCHED;
            PG8_LDB(B0, 1, 0); PG8_LDB(B1, 1, 1); PG8_SCHED; PG8_LDA(At, 1, 0); PG8_STAGE(PG8_SA(0, 1), a2, xA1);
            PG8_WAIT_V(8); PG8_WAIT_L(0); PG8_BAR; PG8_MMA(0, 0, At, B0); PG8_MMA(0, 1, At, B1); PG8_BAR; PG8_SCHED;
            PG8_LDA(At, 1, 1); PG8_STAGE(PG8_SB(1, 0), b3, voffB); PG8_STAGE(PG8_SB(1, 1), b3 + hstep, voffB); PG8_STAGE(PG8_SA(1, 0), a3, xA0);
            PG8_WAIT_V(8); PG8_WAIT_L(0); PG8_BAR; PG8_MMA(1, 0, At, B0); PG8_MMA(1, 1, At, B1); PG8_BAR; PG8_SCHED;
        }
        if constexpr (ALIGN_EPI) { if (wr == 0) PG8_BAR; }
        const bool keep = E(acc, cur, wr, wc, fr, fq);
        if (!has_next) break;
        if (!keep) {
#pragma unroll
            for (int a = 0; a < 2; ++a)
#pragma unroll
                for (int b = 0; b < 2; ++b)
#pragma unroll
                    for (int m = 0; m < 4; ++m)
#pragma unroll
                        for (int n = 0; n < 2; ++n) acc[a][b][m][n] = (f32x4){0.f, 0.f, 0.f, 0.f};
        }
        cur = nxt; cA = nA; cB = nB; ++ui;
        if constexpr (GATHER) {
#pragma unroll
            for (int i = 0; i < 2; ++i) { vA0[i] = nA0[i]; vA1[i] = nA1[i]; }
        }
        if constexpr (ALIGN_EPI) { if (wr == 1) PG8_BAR; }
    }
    PG8_WAIT_V(0);
    if constexpr (!ALIGN_EPI) { if (wr == 0) PG8_BAR; }
    PG8_BAR;
#undef PG8_SA
#undef PG8_SB
#undef PG8_STAGE
#undef PG8_LDA
#undef PG8_LDB
#undef PG8_MMA
#undef PG8_WAIT_V
#undef PG8_WAIT_L
#undef PG8_BAR
#undef PG8_SCHED
}
}

#define XB_TMO      128
#define XB_XCNT(j)  (256  + 64 * (j))
#define XB_XSUB(j)  (1280 + 64 * (j))
#define XB_XGEN(j)  (2304 + 64 * (j))
#define XB_TOP      3328
#define XB_TOPGEN   3392
#define XCD_BAR_WORDS 3456
#define XB_SPIN_CAP (1u << 18)
__device__ __forceinline__ unsigned xb_ld(unsigned* p)              { return __hip_atomic_load(p, __ATOMIC_RELAXED, __HIP_MEMORY_SCOPE_AGENT); }
__device__ __forceinline__ unsigned xb_add(unsigned* p, unsigned v) { return __hip_atomic_fetch_add(p, v, __ATOMIC_RELAXED, __HIP_MEMORY_SCOPE_AGENT); }
__device__ __forceinline__ unsigned xb_xcc_id() { return (unsigned)__builtin_amdgcn_s_getreg((3 << 11) | 20) & 0xFu; }
#define XB_SPIN(cond, bar) do { unsigned _sp = 0; while (cond) { __builtin_amdgcn_s_sleep(1); \
    if ((++_sp & 255u) == 0u) { if (xb_ld(&(bar)[XB_TMO])) break; if (_sp > XB_SPIN_CAP) { atomicAdd(&(bar)[XB_TMO], 1u); break; } } } } while (0)
struct XcdBarrier { unsigned* bar; unsigned x; volatile LAS unsigned* st; };
__device__ __forceinline__ XcdBarrier xcd_barrier_post(unsigned* bar, volatile LAS unsigned* st) {
    XcdBarrier b; b.bar = bar; b.x = xb_xcc_id(); b.st = st;
    if (threadIdx.x == 0) (void)xb_add(&bar[XB_XCNT(b.x)], 1u);
    return b;
}
__device__ __forceinline__ void xcd_barrier_complete(unsigned* bar, unsigned x, unsigned& nloc, unsigned& nx) {
    const unsigned G = gridDim.x * gridDim.y * gridDim.z;
    unsigned sum, cnt, mine, sp = 0u;
    for (;;) {
        sum = 0u; cnt = 0u; mine = 0u;
#pragma unroll
        for (unsigned j = 0; j < 16; ++j) { const unsigned c = xb_ld(&bar[XB_XCNT(j)]); sum += c; cnt += (c > 0u) ? 1u : 0u; mine = (j == x) ? c : mine; }
        if (sum == G) break;
        __builtin_amdgcn_s_sleep(1);
        if ((++sp & 255u) == 0u) { if (xb_ld(&bar[XB_TMO])) break; if (sp > XB_SPIN_CAP) { atomicAdd(&bar[XB_TMO], 1u); break; } }
    }
    nloc = mine > 0u ? mine : 1u; nx = cnt > 0u ? cnt : 1u;
}
__device__ __forceinline__ void xcd_barrier(const XcdBarrier& b) {
    asm volatile("s_waitcnt vmcnt(0)" ::: "memory");
    __syncthreads();
    if (threadIdx.x == 0) {
        unsigned* bar = b.bar;
        __builtin_amdgcn_s_waitcnt(0);
        unsigned nloc = b.st[0], nx = b.st[1];
        if (nloc == 0u) { xcd_barrier_complete(bar, b.x, nloc, nx); b.st[0] = nloc; b.st[1] = nx; }
        const unsigned old = xb_add(&bar[XB_XSUB(b.x)], 1u);
        const unsigned gen = old / nloc;
        if (old + 1u == (gen + 1u) * nloc) {
            __builtin_amdgcn_fence(__ATOMIC_RELEASE, "agent");
            asm volatile("s_waitcnt vmcnt(0)" ::: "memory");
            const unsigned og = xb_add(&bar[XB_TOP], 1u);
            const unsigned tg = og / nx;
            if (og + 1u == (tg + 1u) * nx) xb_add(&bar[XB_TOPGEN], 1u);
            else XB_SPIN(xb_ld(&bar[XB_TOPGEN]) == tg, bar);
            __builtin_amdgcn_fence(__ATOMIC_ACQUIRE, "agent");
            xb_add(&bar[XB_XGEN(b.x)], 1u);
            asm volatile("s_waitcnt vmcnt(0)" ::: "memory");
        } else {
            XB_SPIN(xb_ld(&bar[XB_XGEN(b.x)]) == gen, bar);
            __builtin_amdgcn_fence(__ATOMIC_ACQUIRE, "agent");
            asm volatile("s_waitcnt vmcnt(0)" ::: "memory");
        }
    }
    __syncthreads();
}

struct Args {
    const float *x, *c, *ctx, *c_ctx, *w_ada, *b_ada, *norm1_g, *w_in, *w_conv, *b_conv, *w_a, *w_b, *sink, *w_o, *norm2_g, *w_group, *b_group, *w_router, *b_router, *w_up, *w_down, *final_g;
    float* out; unsigned char* ws; int ph_lo, ph_hi;
};

__device__ const float ROPE_INV[16] = {1.0f, 0.5623413251903491f, 0.31622776601683794f, 0.1778279410038923f, 0.1f, 0.05623413251903491f, 0.031622776601683794f, 0.01778279410038923f,
                                       0.01f, 0.005623413251903491f, 0.0031622776601683794f, 0.001778279410038923f, 0.001f, 5.623413251903491e-4f, 3.1622776601683794e-4f, 1.778279410038923e-4f};
__device__ __forceinline__ void sincos_acc(float angf, float& s, float& c) {
    const double TWO_PI = 6.283185307179586476925;
    double a = (double)angf; const double k = __builtin_rint(a / TWO_PI); const double r = a - k * TWO_PI, r2 = r * r;
    double cs = 1.0, sn = 1.0;
#pragma unroll
    for (int n = 12; n >= 1; --n) { cs = 1.0 - cs * r2 / (double)((2 * n - 1) * (2 * n)); sn = 1.0 - sn * r2 / (double)((2 * n) * (2 * n + 1)); }
    s = (float)(sn * r); c = (float)cs;
}

template <class SrcMap>
__device__ __forceinline__ void transpose_item(const float* W, int K, int N, bf16_t* WT, LAS float* scr, int item, int lane, const SrcMap& src) {
    const int nblk = N / 32, kb = item / nblk, nb = item % nblk, k0 = 64 * kb, n0 = 32 * nb;
    const int sc = src(n0 + (lane & 31));
#pragma unroll 8
    for (int i = 0; i < 32; ++i) { const int kk = 2 * i + (lane >> 5); scr[kk * 33 + (lane & 31)] = W[(size_t)(k0 + kk) * N + sc]; }
    LDS_WAIT(); asm volatile("" ::: "memory");
    const int c = lane & 7;
#pragma unroll
    for (int j = 0; j < 4; ++j) { const int n = (lane >> 3) + 8 * j; const LAS float* s = scr + (8 * c) * 33 + n;
        u32x4 o; o.x = pk2(s[0 * 33], s[1 * 33]); o.y = pk2(s[2 * 33], s[3 * 33]); o.z = pk2(s[4 * 33], s[5 * 33]); o.w = pk2(s[6 * 33], s[7 * 33]);
        *(GAS u32x4*)(WT + (size_t)(n0 + n) * K + k0 + 8 * c) = o; }
    LDS_WAIT(); asm volatile("" ::: "memory");
}
struct MapId { __device__ __forceinline__ int operator()(int r) const { return r; } };
struct MapIn { __device__ __forceinline__ int operator()(int r) const { if (r >= C_Q && r < C_V) { const int p = r & 63; return (r & ~63) + 4 * (p >> 3) + (p & 3) + 32 * ((p >> 2) & 1); } return r; } };
struct MapUp { __device__ __forceinline__ int operator()(int r) const { const int pn = r >> 8, p = r & 255; return 128 * pn + 4 * (p >> 3) + (p & 3) + 256 * ((p >> 2) & 1); } };

__device__ __forceinline__ void p0_prologue(const Args& a, LAS unsigned char* lds, int tid, int lane, int wave) {
    unsigned char* ws = a.ws;
    const int G = gridDim.x;
    {
        LAS float* S = (LAS float*)lds;
        LAS float* R = (LAS float*)(lds + 36864);
        float* mod = (float*)(ws + WS_MOD);
        bool have = false;
        for (int task = blockIdx.x; task < 192; task += G) {
            if (!have) {
                for (int idx = tid; idx < 9 * 1024; idx += 512) { const int b = idx >> 10, k = idx & 1023; const float v = (b < 8) ? a.c[b * 1024 + k] : a.c_ctx[k]; S[idx] = v / (1.0f + __expf(-v)); }
                have = true;
            }
            __syncthreads();
            const int c4 = tid & 7, kr = tid >> 3;
            f32x4 acc[9];
#pragma unroll
            for (int b = 0; b < 9; ++b) acc[b] = (f32x4){0.f, 0.f, 0.f, 0.f};
            const float* wp = a.w_ada + (size_t)kr * 6144 + 32 * task + 4 * c4;
#pragma unroll 4
            for (int it = 0; it < 16; ++it) { const f32x4 w = *(const f32x4*)(wp + (size_t)it * 64 * 6144); const int k = kr + 64 * it;
#pragma unroll
                for (int b = 0; b < 9; ++b) acc[b] += S[b * 1024 + k] * w; }
#pragma unroll
            for (int b = 0; b < 9; ++b) *(LAS f32x4*)(R + (kr * 9 + b) * 32 + 4 * c4) = acc[b];
            __syncthreads();
            if (tid < 288) { const int b = tid >> 5, col = tid & 31; float s = 0.f;
                for (int k2 = 0; k2 < 64; ++k2) s += R[(k2 * 9 + b) * 32 + col];
                mod[b * 6144 + 32 * task + col] = s + a.b_ada[32 * task + col]; }
            __syncthreads();
        }
        __syncthreads();
    }
    {
        float* cosT = (float*)(ws + WS_ROPE); float* sinT = cosT + 2048 * 32;
        for (int idx = blockIdx.x * 512 + tid; idx < 2048 * 32; idx += G * 512) { const int t = idx >> 5, i = idx & 31;
            const float pos = (i < 16) ? (float)(t >> 6) : (float)(t & 63); const float ang = pos * ROPE_INV[i & 15]; float s, c; sincos_acc(ang, s, c); cosT[idx] = c; sinT[idx] = s; }
        bf16_t* wrh = (bf16_t*)(ws + WS_WR); bf16_t* wrl = wrh + 48 * 1024;
        for (int idx = blockIdx.x * 512 + tid; idx < 48 * 1024; idx += G * 512) { const int n = idx >> 10, k = idx & 1023;
            float v = 0.f; if (n < 4) v = a.w_group[k * 4 + n]; else if (n < 36) v = a.w_router[k * 32 + (n - 4)];
            const unsigned h = f2bf(v); const float rem = v - bf2f((unsigned short)h); wrh[idx] = (bf16_t)h; wrl[idx] = (bf16_t)f2bf(rem); }
    }
    {
        LAS float* scr = (LAS float*)(lds + wave * 16384);
        const int gw = blockIdx.x * 8 + wave, NGW = G * 8;
        constexpr int I_IN = 16 * 136, I_A = 8 * 32, I_O = 16 * 32, I_UP = 16 * 16, I_DN = 4 * 32;
        constexpr int NITEMS = I_IN + 2 * I_A + I_O + 32 * I_UP + 32 * I_DN;
        for (int it = gw; it < NITEMS; it += NGW) {
            int r = it;
            if (r < I_IN) { transpose_item(a.w_in, 1024, NIN, (bf16_t*)(ws + WS_WIN), scr, r, lane, MapIn()); continue; } r -= I_IN;
            if (r < I_A) { transpose_item(a.w_a, 512, 1024, (bf16_t*)(ws + WS_WA), scr, r, lane, MapId()); continue; } r -= I_A;
            if (r < I_A) { transpose_item(a.w_b, 512, 1024, (bf16_t*)(ws + WS_WB), scr, r, lane, MapId()); continue; } r -= I_A;
            if (r < I_O) { transpose_item(a.w_o, 1024, 1024, (bf16_t*)(ws + WS_WO), scr, r, lane, MapId()); continue; } r -= I_O;
            if (r < 32 * I_UP) { const int e = r / I_UP; transpose_item(a.w_up + (size_t)e * 1024 * 512, 1024, 512, (bf16_t*)(ws + WS_WUP) + (size_t)e * 512 * 1024, scr, r % I_UP, lane, MapUp()); continue; } r -= 32 * I_UP;
            { const int e = r / I_DN; transpose_item(a.w_down + (size_t)e * 256 * 1024, 256, 1024, (bf16_t*)(ws + WS_WDN) + (size_t)e * 1024 * 256, scr, r % I_DN, lane, MapId()); }
        }
    }
}

__device__ __forceinline__ void p1_norm1(const Args& a, int lane, int wave) {
    const float* mod = (const float*)(a.ws + WS_MOD);
    bf16_t* H = (bf16_t*)((unsigned char*)a.out + DO_H);
    const int gw = blockIdx.x * 8 + wave, NGW = gridDim.x * 8;
    const int rpw = (MALL + NGW - 1) / NGW;
    const int r0 = gw * rpw, r1 = (r0 + rpw < MALL) ? r0 + rpw : MALL;
    int curb = -1; f32x4 A[4], B[4];
#pragma unroll
    for (int j = 0; j < 4; ++j) { A[j] = (f32x4){0.f, 0.f, 0.f, 0.f}; B[j] = A[j]; }
    for (int m = r0; m < r1; ++m) {
        const int b = (m < MLAT) ? (m >> 11) : 8;
        if (b != curb) { curb = b;
#pragma unroll
            for (int j = 0; j < 4; ++j) { const int idx = 4 * lane + 256 * j; const f32x4 g = *(const f32x4*)(a.norm1_g + idx), sc = *(const f32x4*)(mod + b * 6144 + 1024 + idx); A[j] = g * (1.0f + sc); B[j] = *(const f32x4*)(mod + b * 6144 + idx); } }
        const float* xr = (m < MLAT) ? a.x + (size_t)m * DM : a.ctx + (size_t)(m - MLAT) * DM;
        f32x4 v[4]; float s = 0.f;
#pragma unroll
        for (int j = 0; j < 4; ++j) { v[j] = *(const f32x4*)(xr + 4 * lane + 256 * j); s += (v[j].x * v[j].x + v[j].y * v[j].y) + (v[j].z * v[j].z + v[j].w * v[j].w); }
        const float inv = 1.0f / sqrtf(wave_sum(s) * (1.0f / DM) + NORM_EPS);
        bf16_t* orow = H + (size_t)m * DM;
#pragma unroll
        for (int j = 0; j < 4; ++j) { const f32x4 h = (v[j] * inv) * A[j] + B[j]; u32x2 w; w.x = pk2(h.x, h.y); w.y = pk2(h.z, h.w); *(u32x2*)(orow + 4 * lane + 256 * j) = w; }
    }
}

struct SchedIn {
    int G, c; const char* A; const char* Bt;
    __device__ __forceinline__ bool next(int i, pg8::Unit& u) const {
        const long L = (long)i * G + c; constexpr int NW = 64 * 17;
        if (L >= NW + 8) return false;
        if (L >= NW) { u.pm = 64 + (int)(L - NW); u.pn = 8; u.aux = 1; return true; }
        pg8::static_map(64, 17, (int)L, u.pm, u.pn); u.aux = 0; return true;
    }
    __device__ __forceinline__ const char* abase(const pg8::Unit& u) const { return A + (size_t)u.pm * (256 * 1024 * 2); }
    __device__ __forceinline__ const char* bbase(const pg8::Unit& u) const { return Bt + (size_t)u.pn * (256 * 1024 * 2); }
    __device__ __forceinline__ int arow(const pg8::Unit&, int) const { return 0; }
};
struct EpiIn {
    static constexpr bool PERM = true;
    bf16_t* U; bf16_t* KVC; const float* cosT; const float* sinT;
    __device__ __forceinline__ bool operator()(pg8::Acc& acc, const pg8::Unit& u, int wr, int wc, int fr, int fq) const {
        const bool isctx = u.aux != 0;
        const int row0 = (isctx ? (u.pm - 64) : u.pm) * 256 + wr * 64 + fr;
        bf16_t* base = isctx ? KVC : U; const int ldc = isctx ? 256 : NIN; const int coff = isctx ? -C_K : 0;
        const int pi = 16 * (wc & 1) + 4 * fq;
#pragma unroll
        for (int ai = 0; ai < 2; ++ai)
#pragma unroll
            for (int m = 0; m < 4; ++m) {
                const int row = row0 + ai * 128 + m * 16;
                bf16_t* rowp = base + (size_t)row * ldc + coff;
                f32x4 cs = (f32x4){1.f, 1.f, 1.f, 1.f}, sn = (f32x4){0.f, 0.f, 0.f, 0.f};
                if (!isctx && u.pn >= 6 && u.pn <= 8) { const int t = row & (SEQ - 1); cs = *(const f32x4*)(cosT + t * 32 + pi); sn = *(const f32x4*)(sinT + t * 32 + pi); }
#pragma unroll
                for (int bj = 0; bj < 2; ++bj) {
                    const int c0 = u.pn * 256 + bj * 128 + wc * 32 + 8 * fq;
                    const f32x4 v0 = acc[ai][bj][m][0], v1 = acc[ai][bj][m][1];
                    const bool rot = (u.pn == 6) || (u.pn == 7) || (u.pn == 8 && bj == 0);
                    if (rot) {
                        const float sc = (u.pn == 8) ? 1.0f : QSCALE;
                        const f32x4 o1 = (v0 * cs - v1 * sn) * sc, o2 = (v0 * sn + v1 * cs) * sc;
                        const int hb = c0 & ~63, f0 = 4 * ((c0 & 63) >> 3);
                        u32x2 w1, w2; w1.x = cvt_pk_bf16(o1[0], o1[1]); w1.y = cvt_pk_bf16(o1[2], o1[3]); w2.x = cvt_pk_bf16(o2[0], o2[1]); w2.y = cvt_pk_bf16(o2[2], o2[3]);
                        *(u32x2*)(rowp + hb + f0) = w1; *(u32x2*)(rowp + hb + f0 + 32) = w2;
                    } else {
                        u32x4 w; w.x = cvt_pk_bf16(v0[0], v0[1]); w.y = cvt_pk_bf16(v0[2], v0[3]); w.z = cvt_pk_bf16(v1[0], v1[1]); w.w = cvt_pk_bf16(v1[2], v1[3]);
                        *(u32x4*)(rowp + c0) = w;
                    }
                }
            }
        return false;
    }
};

namespace att {
constexpr int NSLOT = 3, SLOTB = 8192;
constexpr int LDS_K = 0, LDS_V = NSLOT * SLOTB, LDS_WS = 2 * NSLOT * SLOTB, LDS_OST = LDS_WS + 8 * 64 * 4, LDS_TOTAL = LDS_OST + 8 * 4096;
__device__ __forceinline__ int crow(int r, int hi) { return (r & 3) + 8 * (r >> 2) + 4 * hi; }
__device__ __forceinline__ void glds16(const void* gsrc, unsigned lds_dst) { unsigned keep;
    asm volatile("s_mov_b32 %0, m0\n\ts_mov_b32 m0, %2\n\ts_nop 0\n\tglobal_load_lds_dwordx4 %1, off\n\ts_mov_b32 m0, %0" : "=&s"(keep) : "v"(gsrc), "s"(lds_dst) : "memory"); }
#define ATT_WAIT_BAR(N) asm volatile("s_waitcnt vmcnt(" #N ") lgkmcnt(0)\n\ts_barrier" ::: "memory")
__device__ __forceinline__ void qkt(f32x16& p0, f32x16& p1, const char* Kslot, const bf16x8* qr, int r32, int hi) {
    const char* kb = Kslot + hi * 1024 + r32 * 16;
    const f32x16 z = f32x16{};
#pragma unroll
    for (int d0 = 0; d0 < 4; ++d0) {
        const bf16x8 b0 = *reinterpret_cast<const bf16x8*>(kb + d0 * 2048);
        const bf16x8 b1 = *reinterpret_cast<const bf16x8*>(kb + d0 * 2048 + 512);
        if (d0 == 0) { p0 = __builtin_amdgcn_mfma_f32_32x32x16_bf16(b0, qr[0], z, 0, 0, 0); p1 = __builtin_amdgcn_mfma_f32_32x32x16_bf16(b1, qr[0], z, 0, 0, 0); }
        else { p0 = __builtin_amdgcn_mfma_f32_32x32x16_bf16(b0, qr[d0], p0, 0, 0, 0); p1 = __builtin_amdgcn_mfma_f32_32x32x16_bf16(b1, qr[d0], p1, 0, 0, 0); }
    }
}
__device__ __forceinline__ void pv(f32x16* o, int vb, bf16x8 pa0, bf16x8 pa1, bf16x8 pa2, bf16x8 pa3) {
#pragma unroll
    for (int d0 = 0; d0 < 2; ++d0) { s16x4 lo[4], hi[4];
#pragma unroll
        for (int ks = 0; ks < 4; ++ks) {
            asm volatile("ds_read_b64_tr_b16 %0,%1 offset:%c2" : "=&v"(lo[ks]) : "v"(vb), "i"(d0 * 4096 + ks * 1024) : "memory");
            asm volatile("ds_read_b64_tr_b16 %0,%1 offset:%c2" : "=&v"(hi[ks]) : "v"(vb), "i"(d0 * 4096 + ks * 1024 + 512) : "memory"); }
        asm volatile("s_waitcnt lgkmcnt(0)" ::: "memory"); __builtin_amdgcn_sched_barrier(0);
#define ATT_PK(k) (bf16x8){lo[k][0], lo[k][1], lo[k][2], lo[k][3], hi[k][0], hi[k][1], hi[k][2], hi[k][3]}
        o[d0] = __builtin_amdgcn_mfma_f32_32x32x16_bf16(pa0, ATT_PK(0), o[d0], 0, 0, 0);
        o[d0] = __builtin_amdgcn_mfma_f32_32x32x16_bf16(pa1, ATT_PK(1), o[d0], 0, 0, 0);
        o[d0] = __builtin_amdgcn_mfma_f32_32x32x16_bf16(pa2, ATT_PK(2), o[d0], 0, 0, 0);
        o[d0] = __builtin_amdgcn_mfma_f32_32x32x16_bf16(pa3, ATT_PK(3), o[d0], 0, 0, 0);
#undef ATT_PK
    }
}
__device__ __forceinline__ void attn_unit(int b, int kvh, int qb, int hp, const bf16_t* U, const bf16_t* KVC, bf16_t* O, const float* sink, char* shm) {
    const int tid = threadIdx.x, lane = tid & 63, r32 = lane & 31, hi = lane >> 5; const int wid = __builtin_amdgcn_readfirstlane(tid >> 6);
    const int head = 4 * kvh + 2 * hp + (wid >> 2), qoff = 32 * (wid & 3);
    const size_t qrow0 = (size_t)b * SEQ + qb * 128 + qoff;
    const unsigned lds0 = (unsigned)(uintptr_t)shm;
    float* wsf = (float*)(shm + LDS_WS) + wid * 64;
    const int jlo = (qb == 0) ? 2 : 0, jhi = (qb == SEQ / 128 - 1) ? 4 : 6, nwin = jhi - jlo, NT = nwin + 4;
    const bf16_t* kwin = U + ((size_t)b * SEQ + (size_t)lane) * NIN + C_K + kvh * 64 + wid * 8;
    const bf16_t* vwin = U + ((size_t)b * SEQ + (size_t)(16 * (wid & 3) + (lane >> 2))) * NIN + C_V + kvh * 64 + (wid >> 2) * 32 + (lane & 3) * 8;
    const bf16_t* kctx = KVC + ((size_t)b * CTXL + (size_t)lane) * 256 + kvh * 64 + wid * 8;
    const bf16_t* vctx = KVC + ((size_t)b * CTXL + (size_t)(16 * (wid & 3) + (lane >> 2))) * 256 + 128 + kvh * 64 + (wid >> 2) * 32 + (lane & 3) * 8;
    const unsigned kdst = lds0 + LDS_K + wid * 1024, vdst = lds0 + LDS_V + wid * 1024;
    const int kw0 = qb * 128 - 128 + 64 * jlo;
#define ATT_DMA(t, slot) do { const int t_ = (t); const unsigned so_ = (unsigned)(slot); \
        if (t_ < nwin) { const size_t ro_ = (size_t)(kw0 + 64 * t_) * NIN; glds16(kwin + ro_, (unsigned)__builtin_amdgcn_readfirstlane(kdst + so_)); glds16(vwin + ro_, (unsigned)__builtin_amdgcn_readfirstlane(vdst + so_)); } \
        else { const size_t ro_ = (size_t)(64 * (t_ - nwin)) * 256; glds16(kctx + ro_, (unsigned)__builtin_amdgcn_readfirstlane(kdst + so_)); glds16(vctx + ro_, (unsigned)__builtin_amdgcn_readfirstlane(vdst + so_)); } } while (0)
    const bf16_t* Qw = U + qrow0 * NIN + C_Q + head * 64;
    bf16x8 qr[4];
#pragma unroll
    for (int d0 = 0; d0 < 4; ++d0) qr[d0] = *reinterpret_cast<const bf16x8*>(&Qw[(size_t)r32 * NIN + d0 * 16 + hi * 8]);
    ATT_DMA(0, 0); ATT_DMA(1, SLOTB);
    const float sk = sink[head] * LOG2E;
    float mrun = sk, l_reg = (hi == 0) ? 1.0f : 0.0f;
    f32x16 o[2]; o[0] = f32x16{}; o[1] = f32x16{};
    const int vb0 = (int)(lds0 + LDS_V) + ((lane >> 4) & 1) * 32 + (lane & 3) * 8 + (4 * hi + ((lane & 15) >> 2)) * 64;
    int slot = 0;
    for (int t = 0; t < NT; ++t) {
        if (t + 1 < NT) { ATT_WAIT_BAR(2); } else { ATT_WAIT_BAR(0); }
        if (t + 2 < NT) { const int s2 = (slot >= SLOTB) ? slot - SLOTB : slot + 2 * SLOTB; ATT_DMA(t + 2, s2); }
        bool skip = false; int mbase = 0;
        if (t < nwin) { const int kr0 = 64 * (jlo + t) - 128; skip = (kr0 - (qoff + 31) > 128) || (qoff - (kr0 + 63) > 128); mbase = kr0 - (qoff + r32); }
        if (!skip) {
            f32x16 p0, p1;
            qkt(p0, p1, shm + LDS_K + slot, qr, r32, hi);
            if (t < nwin) {
#pragma unroll
                for (int r = 0; r < 16; ++r) { const int d = mbase + crow(r, hi); if (d < -128 || d > 128) p0[r] = -1e30f; if (d + 32 < -128 || d + 32 > 128) p1[r] = -1e30f; }
            }
            float rm = fmaxf(p0[0], p1[0]);
#pragma unroll
            for (int r = 1; r < 16; ++r) rm = fmaxf(rm, fmaxf(p0[r], p1[r]));
            { auto rr = __builtin_amdgcn_permlane32_swap(__float_as_uint(rm), __float_as_uint(rm), false, false); rm = fmaxf(__uint_as_float(rr[0]), __uint_as_float(rr[1])); }
            const float mn = fmaxf(mrun, rm);
            const float alpha = __builtin_amdgcn_exp2f(mrun - mn);
            const bool resc = __any(mn > mrun);
            mrun = mn;
            float sacc = 0.f;
#pragma unroll
            for (int r = 0; r < 16; ++r) { p0[r] = __builtin_amdgcn_exp2f(p0[r] - mn); p1[r] = __builtin_amdgcn_exp2f(p1[r] - mn); sacc += p0[r] + p1[r]; }
            l_reg = l_reg * alpha + sacc;
            if (resc) {
                if (hi == 0) wsf[r32] = alpha;
                asm volatile("s_waitcnt lgkmcnt(0)" ::: "memory");
#pragma unroll
                for (int r = 0; r < 16; ++r) { const float f = wsf[crow(r, hi)]; o[0][r] *= f; o[1][r] *= f; }
                asm volatile("s_waitcnt lgkmcnt(0)" ::: "memory");
            }
            u32x4 pw0, pw1, pw2, pw3;
            pw0 = (u32x4){cvt_pk_bf16(p0[0], p0[1]), cvt_pk_bf16(p0[2], p0[3]), cvt_pk_bf16(p0[4], p0[5]), cvt_pk_bf16(p0[6], p0[7])};
            pw1 = (u32x4){cvt_pk_bf16(p0[8], p0[9]), cvt_pk_bf16(p0[10], p0[11]), cvt_pk_bf16(p0[12], p0[13]), cvt_pk_bf16(p0[14], p0[15])};
            pw2 = (u32x4){cvt_pk_bf16(p1[0], p1[1]), cvt_pk_bf16(p1[2], p1[3]), cvt_pk_bf16(p1[4], p1[5]), cvt_pk_bf16(p1[6], p1[7])};
            pw3 = (u32x4){cvt_pk_bf16(p1[8], p1[9]), cvt_pk_bf16(p1[10], p1[11]), cvt_pk_bf16(p1[12], p1[13]), cvt_pk_bf16(p1[14], p1[15])};
            __builtin_amdgcn_sched_barrier(0);
            pv(o, vb0 + slot, __builtin_bit_cast(bf16x8, pw0), __builtin_bit_cast(bf16x8, pw1), __builtin_bit_cast(bf16x8, pw2), __builtin_bit_cast(bf16x8, pw3));
        }
        slot = (slot == (NSLOT - 1) * SLOTB) ? 0 : slot + SLOTB;
    }
    { auto rr = __builtin_amdgcn_permlane32_swap(__float_as_uint(l_reg), __float_as_uint(l_reg), false, false); l_reg = __uint_as_float(rr[0]) + __uint_as_float(rr[1]); }
    if (hi == 0) wsf[32 + r32] = l_reg;
    asm volatile("s_waitcnt lgkmcnt(0)" ::: "memory");
    float rli[16];
#pragma unroll
    for (int r = 0; r < 16; ++r) rli[r] = 1.0f / wsf[32 + crow(r, hi)];
    bf16_t* Ow = O + qrow0 * 512 + head * 64;
    { bf16_t* stg = (bf16_t*)(shm + LDS_OST) + wid * 2048;
#pragma unroll
        for (int r = 0; r < 16; ++r) { const int orow = crow(r, hi);
#pragma unroll
            for (int d0 = 0; d0 < 2; ++d0) stg[orow * 64 + d0 * 32 + r32] = (bf16_t)f2bf(o[d0][r] * rli[r]); }
        asm volatile("s_waitcnt lgkmcnt(0)" ::: "memory");
#pragma unroll
        for (int i = 0; i < 4; ++i) { const int row = i * 8 + (lane >> 3), ch = lane & 7; const u32x4 v = *(const u32x4*)(stg + row * 64 + ch * 8); *(u32x4*)(Ow + (size_t)row * 512 + ch * 8) = v; } }
    asm volatile("s_waitcnt vmcnt(0) lgkmcnt(0)\n\ts_barrier" ::: "memory");
#undef ATT_DMA
}
#undef ATT_WAIT_BAR
}

__device__ __forceinline__ void p3_attn_conv(const Args& a, char* lds_generic, int tid) {
    const bf16_t* U = (const bf16_t*)(a.ws + WS_U); const bf16_t* KVC = (const bf16_t*)(a.ws + WS_KVC);
    bf16_t* O = (bf16_t*)((unsigned char*)a.out + DO_O); bf16_t* A1 = (bf16_t*)((unsigned char*)a.out + DO_A1);
    const int G = gridDim.x;
    constexpr int NU = NBATCH * 2 * 16 * 2;
    const int per = (NU + G - 1) / G;
    for (int i = 0; i < per; ++i) { const int id = blockIdx.x * per + i; if (id >= NU) break;
        const int hp = id & 1, qb = (id >> 1) & 15, kvh = (id >> 5) & 1, b = id >> 6;
        att::attn_unit(b, kvh, qb, hp, U, KVC, O, a.sink, lds_generic); }
    for (int task = blockIdx.x * 512 + tid; task < (MLAT / 8) * 64; task += G * 512) {
        const int cch = task & 63, rg = task >> 6, c0 = 8 * cch, t0 = 8 * rg;
        float w0[8], w1[8], w2[8], bc[8];
#pragma unroll
        for (int q = 0; q < 2; ++q) { const f32x4 x0 = *(const f32x4*)(a.w_conv + c0 + 4 * q), x1 = *(const f32x4*)(a.w_conv + 512 + c0 + 4 * q), x2 = *(const f32x4*)(a.w_conv + 1024 + c0 + 4 * q), xb = *(const f32x4*)(a.b_conv + c0 + 4 * q);
#pragma unroll
            for (int e = 0; e < 4; ++e) { w0[4 * q + e] = x0[e]; w1[4 * q + e] = x1[e]; w2[4 * q + e] = x2[e]; bc[4 * q + e] = xb[e]; } }
        float up[8], uc[8], un[8];
        const int tl = t0 & (SEQ - 1);
#define CONV_LOADU(dst, t, valid) do { if (valid) { const u32x4 cg_ = *(const u32x4*)(U + (size_t)(t) * NIN + C_CG + c0), xi_ = *(const u32x4*)(U + (size_t)(t) * NIN + C_X + c0); \
            _Pragma("unroll") for (int e = 0; e < 4; ++e) { dst[2 * e] = bflo(cg_[e]) * bflo(xi_[e]); dst[2 * e + 1] = bfhi(cg_[e]) * bfhi(xi_[e]); } } \
            else { _Pragma("unroll") for (int e = 0; e < 8; ++e) dst[e] = 0.f; } } while (0)
        CONV_LOADU(up, t0 - 1, tl > 0);
        CONV_LOADU(uc, t0, true);
#pragma unroll
        for (int r = 0; r < 8; ++r) {
            const int t = t0 + r;
            CONV_LOADU(un, t + 1, (tl + r + 1) < SEQ);
            const u32x4 bb = *(const u32x4*)(U + (size_t)t * NIN + C_B + c0);
            float y[8];
#pragma unroll
            for (int e = 0; e < 8; ++e) y[e] = bc[e] + w0[e] * up[e] + w1[e] * uc[e] + w2[e] * un[e];
            u32x4 w;
#pragma unroll
            for (int e = 0; e < 4; ++e) w[e] = pk2(bflo(bb[e]) * y[2 * e], bfhi(bb[e]) * y[2 * e + 1]);
            *(u32x4*)(A1 + (size_t)t * 512 + c0) = w;
#pragma unroll
            for (int e = 0; e < 8; ++e) { up[e] = uc[e]; uc[e] = un[e]; }
        }
#undef CONV_LOADU
    }
}

struct SchedZ {
    int G, c; const char* A0; const char* A1; const char* B0; const char* B1;
    __device__ __forceinline__ bool next(int i, pg8::Unit& u) const {
        const long L = (long)(i >> 1) * G + c; if (L >= 256) return false;
        pg8::static_map(64, 4, (int)L, u.pm, u.pn); u.aux = i & 1; return true;
    }
    __device__ __forceinline__ const char* abase(const pg8::Unit& u) const { return (u.aux ? A1 : A0) + (size_t)u.pm * (256 * 512 * 2); }
    __device__ __forceinline__ const char* bbase(const pg8::Unit& u) const { return (u.aux ? B1 : B0) + (size_t)u.pn * (256 * 512 * 2); }
    __device__ __forceinline__ int arow(const pg8::Unit&, int) const { return 0; }
};
struct EpiZ {
    static constexpr bool PERM = true;
    const bf16_t* U; bf16_t* Z;
    __device__ __forceinline__ bool operator()(pg8::Acc& acc, const pg8::Unit& u, int wr, int wc, int fr, int fq) const {
        const int row0 = u.pm * 256 + wr * 64 + fr, col0 = u.pn * 256 + wc * 32 + 8 * fq;
#pragma unroll
        for (int ai = 0; ai < 2; ++ai)
#pragma unroll
            for (int m = 0; m < 4; ++m) { const int row = row0 + ai * 128 + m * 16;
#pragma unroll
                for (int bj = 0; bj < 2; ++bj) { const int c = col0 + bj * 128;
                    const u32x4 gbw = *(const u32x4*)(U + (size_t)row * NIN + C_GB + c);
                    f32x4 v0 = acc[ai][bj][m][0], v1 = acc[ai][bj][m][1];
                    if (u.aux == 0) {
                        const u32x4 gaw = *(const u32x4*)(U + (size_t)row * NIN + C_GA + c);
#pragma unroll
                        for (int e = 0; e < 2; ++e) { v0[2 * e] *= sigmoidf_(bflo(gaw[e])) / sigmoidf_(bflo(gbw[e])); v0[2 * e + 1] *= sigmoidf_(bfhi(gaw[e])) / sigmoidf_(bfhi(gbw[e]));
                            v1[2 * e] *= sigmoidf_(bflo(gaw[2 + e])) / sigmoidf_(bflo(gbw[2 + e])); v1[2 * e + 1] *= sigmoidf_(bfhi(gaw[2 + e])) / sigmoidf_(bfhi(gbw[2 + e])); }
                        acc[ai][bj][m][0] = v0; acc[ai][bj][m][1] = v1;
                    } else {
#pragma unroll
                        for (int e = 0; e < 2; ++e) { v0[2 * e] *= sigmoidf_(bflo(gbw[e])); v0[2 * e + 1] *= sigmoidf_(bfhi(gbw[e])); v1[2 * e] *= sigmoidf_(bflo(gbw[2 + e])); v1[2 * e + 1] *= sigmoidf_(bfhi(gbw[2 + e])); }
                        u32x4 w; w.x = cvt_pk_bf16(v0[0], v0[1]); w.y = cvt_pk_bf16(v0[2], v0[3]); w.z = cvt_pk_bf16(v1[0], v1[1]); w.w = cvt_pk_bf16(v1[2], v1[3]);
                        *(u32x4*)(Z + (size_t)row * DM + c) = w;
                    }
                } }
        return u.aux == 0;
    }
};

struct SchedDense {
    int G, c, nM, nN; const char* A; const char* Bt; size_t tstep;
    __device__ __forceinline__ bool next(int i, pg8::Unit& u) const { const long L = (long)i * G + c; if (L >= (long)nM * nN) return false; pg8::static_map(nM, nN, (int)L, u.pm, u.pn); u.aux = 0; return true; }
    __device__ __forceinline__ const char* abase(const pg8::Unit& u) const { return A + (size_t)u.pm * tstep; }
    __device__ __forceinline__ const char* bbase(const pg8::Unit& u) const { return Bt + (size_t)u.pn * tstep; }
    __device__ __forceinline__ int arow(const pg8::Unit&, int) const { return 0; }
};
struct EpiX1 {
    static constexpr bool PERM = false;
    const float* x; const float* mod; float* X1;
    __device__ __forceinline__ bool operator()(pg8::Acc& acc, const pg8::Unit& u, int wr, int wc, int fr, int fq) const {
        const int row0 = u.pm * 256 + wr * 64 + fr, col0 = u.pn * 256 + wc * 32 + 4 * fq; const int b = (u.pm * 256) >> 11;
        f32x4 g[2][2];
#pragma unroll
        for (int bj = 0; bj < 2; ++bj)
#pragma unroll
            for (int n = 0; n < 2; ++n) g[bj][n] = *(const f32x4*)(mod + b * 6144 + 2048 + col0 + bj * 128 + n * 16);
#pragma unroll
        for (int ai = 0; ai < 2; ++ai)
#pragma unroll
            for (int m = 0; m < 4; ++m) { const size_t off = (size_t)(row0 + ai * 128 + m * 16) * DM + col0;
#pragma unroll
                for (int bj = 0; bj < 2; ++bj)
#pragma unroll
                    for (int n = 0; n < 2; ++n) { const f32x4 xv = *(const f32x4*)(x + off + bj * 128 + n * 16); *(f32x4*)(X1 + off + bj * 128 + n * 16) = xv + g[bj][n] * acc[ai][bj][m][n]; }
                if (m & 1) asm volatile("" ::: "memory"); }
        return false;
    }
};

__device__ __forceinline__ void p5_norm2_route(const Args& a, LAS unsigned char* lds, int tid, int lane, int wave) {
    const float* mod = (const float*)(a.ws + WS_MOD); const float* X1 = a.out;
    bf16_t* H2 = (bf16_t*)(a.ws + WS_H2); bf16_t* H2L = (bf16_t*)(a.ws + WS_Z);
    const bf16_t* wrh = (const bf16_t*)(a.ws + WS_WR); const bf16_t* wrl = wrh + 48 * 1024;
    unsigned* gcnt = (unsigned*)(a.ws + WS_CTL) + CW_CNT; i32x2* list = (i32x2*)(a.ws + WS_LIST);
    LAS float* wsl = (LAS float*)(lds + wave * 2048);
    LAS int* hist = (LAS int*)(lds + 16384); LAS int* hbase = hist + 32;
    const int G = gridDim.x;
    for (int chunk = blockIdx.x; chunk < MLAT / 64; chunk += G) {
        const int row0 = chunk * 64 + wave * 8, b = row0 >> 11;
        if (tid < 32) hist[tid] = 0;
        f32x4 A[4], B[4];
#pragma unroll
        for (int j = 0; j < 4; ++j) { const int idx = 4 * lane + 256 * j; const f32x4 g = *(const f32x4*)(a.norm2_g + idx), sc = *(const f32x4*)(mod + b * 6144 + 4096 + idx); A[j] = g * (1.0f + sc); B[j] = *(const f32x4*)(mod + b * 6144 + 3072 + idx); }
        for (int r = 0; r < 8; ++r) {
            const float* xr = X1 + (size_t)(row0 + r) * DM;
            f32x4 v[4]; float s = 0.f;
#pragma unroll
            for (int j = 0; j < 4; ++j) { v[j] = *(const f32x4*)(xr + 4 * lane + 256 * j); s += (v[j].x * v[j].x + v[j].y * v[j].y) + (v[j].z * v[j].z + v[j].w * v[j].w); }
            const float inv = 1.0f / sqrtf(wave_sum(s) * (1.0f / DM) + NORM_EPS);
#pragma unroll
            for (int j = 0; j < 4; ++j) { const f32x4 h = (v[j] * inv) * A[j] + B[j];
                const unsigned h0 = f2bf(h.x), h1 = f2bf(h.y), h2 = f2bf(h.z), h3 = f2bf(h.w);
                u32x2 wh; wh.x = h0 | (h1 << 16); wh.y = h2 | (h3 << 16);
                u32x2 wl; wl.x = pk2(h.x - bf2f((unsigned short)h0), h.y - bf2f((unsigned short)h1)); wl.y = pk2(h.z - bf2f((unsigned short)h2), h.w - bf2f((unsigned short)h3));
                *(u32x2*)(H2 + (size_t)(row0 + r) * DM + 4 * lane + 256 * j) = wh; *(u32x2*)(H2L + (size_t)(row0 + r) * DM + 4 * lane + 256 * j) = wl; }
        }
        VM_WAIT(); __builtin_amdgcn_fence(__ATOMIC_ACQUIRE, "agent"); VM_WAIT();
        f32x4 acc[3];
#pragma unroll
        for (int n = 0; n < 3; ++n) acc[n] = (f32x4){0.f, 0.f, 0.f, 0.f};
        const size_t aoff = (size_t)(row0 + (lane & 7)) * DM + 8 * (lane >> 4);
        const size_t boff = (size_t)(lane & 15) * DM + 8 * (lane >> 4);
#pragma unroll 2
        for (int ks = 0; ks < 32; ++ks) {
            const bf16x8 ah = *(const bf16x8*)(H2 + aoff + 32 * ks), al = *(const bf16x8*)(H2L + aoff + 32 * ks);
#pragma unroll
            for (int n = 0; n < 3; ++n) { const bf16x8 bh = *(const bf16x8*)(wrh + boff + (size_t)n * 16 * DM + 32 * ks), bl = *(const bf16x8*)(wrl + boff + (size_t)n * 16 * DM + 32 * ks);
                acc[n] = __builtin_amdgcn_mfma_f32_16x16x32_bf16(ah, bh, acc[n], 0, 0, 0);
                acc[n] = __builtin_amdgcn_mfma_f32_16x16x32_bf16(al, bh, acc[n], 0, 0, 0);
                acc[n] = __builtin_amdgcn_mfma_f32_16x16x32_bf16(ah, bl, acc[n], 0, 0, 0); }
        }
        if ((lane >> 4) < 2) {
#pragma unroll
            for (int n = 0; n < 3; ++n)
#pragma unroll
                for (int rg = 0; rg < 4; ++rg) wsl[(4 * (lane >> 4) + rg) * 64 + 16 * n + (lane & 15)] = acc[n][rg];
        }
        LDS_WAIT();
        __syncthreads();
        int e0 = 0, e1 = 0, rk0 = 0, rk1 = 0; float gt0 = 0.f, gt1 = 0.f;
        if (lane < 8) {
            const LAS float* lg = wsl + lane * 64;
            float gm = lg[0] + a.b_group[0]; int gi = 0; float gl[4]; gl[0] = gm;
#pragma unroll
            for (int q = 1; q < 4; ++q) { gl[q] = lg[q] + a.b_group[q]; if (gl[q] > gm) { gm = gl[q]; gi = q; } }
            float gs = 0.f;
#pragma unroll
            for (int q = 0; q < 4; ++q) gs += __expf(gl[q] - gm);
            const float pg = 1.0f / gs;
            float m0 = -INFINITY, m1 = -INFINITY; int i0 = 0, i1 = 0;
            for (int q = 0; q < 8; ++q) { const float v = lg[4 + 8 * gi + q] + a.b_router[8 * gi + q];
                if (v > m0) { m1 = m0; i1 = i0; m0 = v; i0 = q; } else if (v > m1) { m1 = v; i1 = q; } }
            const float rr = __expf(m1 - m0), w0 = 1.0f / (1.0f + rr);
            gt0 = pg * w0; gt1 = pg * (rr * w0); e0 = 8 * gi + i0; e1 = 8 * gi + i1;
            rk0 = __hip_atomic_fetch_add((int*)(hist + e0), 1, __ATOMIC_RELAXED, __HIP_MEMORY_SCOPE_WORKGROUP);
            rk1 = __hip_atomic_fetch_add((int*)(hist + e1), 1, __ATOMIC_RELAXED, __HIP_MEMORY_SCOPE_WORKGROUP);
        }
        LDS_WAIT();
        __syncthreads();
        if (tid < 32) { const int n = hist[tid]; hbase[tid] = (n > 0) ? (int)__hip_atomic_fetch_add(gcnt + tid, (unsigned)n, __ATOMIC_RELAXED, __HIP_MEMORY_SCOPE_AGENT) : 0; }
        LDS_WAIT();
        __syncthreads();
        if (lane < 8) { const int tok = row0 + lane;
            list[(size_t)e0 * LISTCAP + hbase[e0] + rk0] = (i32x2){tok * 2, __builtin_bit_cast(int, gt0)};
            list[(size_t)e1 * LISTCAP + hbase[e1] + rk1] = (i32x2){tok * 2 + 1, __builtin_bit_cast(int, gt1)}; }
        __syncthreads();
    }
}

struct SchedMoe {
    int G, c, NPN, total; const LAS int* pref; const LAS int* cnt; const char* A; const char* Bt; size_t a_tstep, b_estride, b_tstep; const i32x2* list;
    __device__ __forceinline__ bool next(int i, pg8::Unit& u) const {
        const long L = (long)i * G + c; if (L >= total) return false;
        const int mt = (int)(L / NPN); u.pn = (int)(L % NPN); u.pm = mt;
        int e = 0;
        for (int q = 1; q < NEXP; ++q) e += (pref[q] <= mt) ? 1 : 0;
        e = __builtin_amdgcn_readfirstlane(e);
        u.aux = e | ((mt - pref[e]) << 8); return true;
    }
    __device__ __forceinline__ const char* abase(const pg8::Unit& u) const { return A + (size_t)u.pm * a_tstep; }
    __device__ __forceinline__ const char* bbase(const pg8::Unit& u) const { return Bt + (size_t)(u.aux & 255) * b_estride + (size_t)u.pn * b_tstep; }
    __device__ __forceinline__ int arow(const pg8::Unit& u, int r) const { const int e = u.aux & 255, idx = (u.aux >> 8) * 256 + r; return (idx < cnt[e]) ? (list[(size_t)e * LISTCAP + idx].x >> 1) : 0; }
};
struct EpiUp {
    static constexpr bool PERM = true;
    bf16_t* ACT;
    __device__ __forceinline__ bool operator()(pg8::Acc& acc, const pg8::Unit& u, int wr, int wc, int fr, int fq) const {
        const int row0 = u.pm * 256 + wr * 64 + fr;
#pragma unroll
        for (int ai = 0; ai < 2; ++ai)
#pragma unroll
            for (int m = 0; m < 4; ++m) { bf16_t* rowp = ACT + (size_t)(row0 + ai * 128 + m * 16) * EFF + 128 * u.pn + 16 * wc + 4 * fq;
#pragma unroll
                for (int bj = 0; bj < 2; ++bj) { const f32x4 av = acc[ai][bj][m][0], uv = acc[ai][bj][m][1]; float y[4];
#pragma unroll
                    for (int e = 0; e < 4; ++e) { const float g = fminf(fmaxf(av[e], -30.f), 30.f); y[e] = av[e] / (1.0f + __expf(-g)) * uv[e]; }
                    u32x2 w; w.x = cvt_pk_bf16(y[0], y[1]); w.y = cvt_pk_bf16(y[2], y[3]); *(u32x2*)(rowp + 64 * bj) = w; } }
        return false;
    }
};
struct EpiDown {
    static constexpr bool PERM = true;
    bf16_t* Y0; bf16_t* dump; const i32x2* list; const LAS int* cnt;
    __device__ __forceinline__ bool operator()(pg8::Acc& acc, const pg8::Unit& u, int wr, int wc, int fr, int fq) const {
        const int e = u.aux & 255, lt = u.aux >> 8, n = cnt[e]; const int col0 = u.pn * 256 + wc * 32 + 8 * fq;
        const i32x2* lp = list + (size_t)e * LISTCAP + lt * 256 + wr * 64 + fr; const int rem = n - (lt * 256 + wr * 64 + fr);
#pragma unroll
        for (int ai = 0; ai < 2; ++ai)
#pragma unroll
            for (int m = 0; m < 4; ++m) { const int o = ai * 128 + m * 16; const bool ok = o < rem;
                const i32x2 en = lp[ok ? o : 0]; const int gbits = en.y; const float gt = __int_as_float(gbits);
                bf16_t* rowp = ok ? (Y0 + (size_t)(en.x & 1) * ((WS_Y1 - WS_Y0) / 2) + (size_t)(en.x >> 1) * DM + col0) : (dump + col0);
#pragma unroll
                for (int bj = 0; bj < 2; ++bj) { const f32x4 v0 = acc[ai][bj][m][0] * gt, v1 = acc[ai][bj][m][1] * gt;
                    u32x4 w; w.x = cvt_pk_bf16(v0[0], v0[1]); w.y = cvt_pk_bf16(v0[2], v0[3]); w.z = cvt_pk_bf16(v1[0], v1[1]); w.w = cvt_pk_bf16(v1[2], v1[3]); *(u32x4*)(rowp + bj * 128) = w; }
                asm volatile("" ::: "memory"); }
        return false;
    }
};
__device__ __forceinline__ int moe_tables(const Args& a, LAS unsigned char* lds, int tid) {
    LAS int* cnt = (LAS int*)(lds + MISC_OFF + 256); LAS int* pref = cnt + 32;
    unsigned* gcnt = (unsigned*)(a.ws + WS_CTL) + CW_CNT;
    __syncthreads();
    if (tid < 32) cnt[tid] = (int)__hip_atomic_load(gcnt + tid, __ATOMIC_RELAXED, __HIP_MEMORY_SCOPE_AGENT);
    LDS_WAIT(); __syncthreads();
    if (tid == 0) { int s = 0; for (int e = 0; e < NEXP; ++e) { pref[e] = s; s += (cnt[e] + 255) >> 8; } pref[NEXP] = s; }
    LDS_WAIT(); __syncthreads();
    return pref[NEXP];
}

__device__ __forceinline__ void p9_final(const Args& a, int lane, int wave) {
    const float* mod = (const float*)(a.ws + WS_MOD); const bf16_t* Y0 = (const bf16_t*)(a.ws + WS_Y0); const bf16_t* Y1 = (const bf16_t*)(a.ws + WS_Y1);
    const int gw = blockIdx.x * 8 + wave, NGW = gridDim.x * 8;
    const int rpw = (MLAT + NGW - 1) / NGW;
    const int r0 = gw * rpw, r1 = (r0 + rpw < MLAT) ? r0 + rpw : MLAT;
    int curb = -1; f32x4 g2[4], fg[4];
#pragma unroll
    for (int j = 0; j < 4; ++j) { fg[j] = *(const f32x4*)(a.final_g + 4 * lane + 256 * j); g2[j] = fg[j]; }
    for (int m = r0; m < r1; ++m) {
        const int b = m >> 11;
        if (b != curb) { curb = b;
#pragma unroll
            for (int j = 0; j < 4; ++j) g2[j] = *(const f32x4*)(mod + b * 6144 + 5120 + 4 * lane + 256 * j); }
        float* xr = a.out + (size_t)m * DM;
        f32x4 v[4]; float s = 0.f;
#pragma unroll
        for (int j = 0; j < 4; ++j) { const int idx = 4 * lane + 256 * j; const f32x4 xv = *(const f32x4*)(xr + idx);
            const u32x2 y0 = *(const u32x2*)(Y0 + (size_t)m * DM + idx), y1 = *(const u32x2*)(Y1 + (size_t)m * DM + idx);
            f32x4 y; y.x = bflo(y0.x) + bflo(y1.x); y.y = bfhi(y0.x) + bfhi(y1.x); y.z = bflo(y0.y) + bflo(y1.y); y.w = bfhi(y0.y) + bfhi(y1.y);
            v[j] = xv + g2[j] * y; s += (v[j].x * v[j].x + v[j].y * v[j].y) + (v[j].z * v[j].z + v[j].w * v[j].w); }
        const float inv = 1.0f / sqrtf(wave_sum(s) * (1.0f / DM) + NORM_EPS);
#pragma unroll
        for (int j = 0; j < 4; ++j) *(f32x4*)(xr + 4 * lane + 256 * j) = (v[j] * inv) * fg[j];
    }
}

__global__ void __launch_bounds__(512, 2) fwd_kernel(Args args) {
    extern __shared__ __attribute__((aligned(16))) unsigned char lds_raw[];
    LAS unsigned char* lds = (LAS unsigned char*)lds_raw;
    const int tid = threadIdx.x, lane = tid & 63, wave = __builtin_amdgcn_readfirstlane(tid >> 6);
    const int G = gridDim.x;
    unsigned char* ws = args.ws;
    volatile LAS unsigned* MISC = (volatile LAS unsigned*)(lds + MISC_OFF);
    for (int u = tid; u < 256; u += 512) MISC[u] = 0u;
    __syncthreads();
    XcdBarrier bar; bar.bar = (unsigned*)(ws + WS_CTL) + CW_BAR; bar.x = 0; bar.st = nullptr;
    if (MK_N_LAUNCHES == 1) bar = xcd_barrier_post((unsigned*)(ws + WS_CTL) + CW_BAR, MISC + 8);
    const int lo = args.ph_lo, hi = args.ph_hi;
#ifndef PHMASK
#define PHMASK 0x3ff
#endif
#define IN(k) (((PHMASK >> (k)) & 1) && lo <= (k) && (k) < hi)
#define SEAM(k) do { if (IN(k) && IN((k) + 1)) xcd_barrier(bar); } while (0)

    if (IN(0)) { p0_prologue(args, lds, tid, lane, wave); SEAM(0); }
    if (IN(1)) { p1_norm1(args, lane, wave); SEAM(1); }
    if (IN(2)) {
        SchedIn S{G, (int)blockIdx.x, (const char*)args.out + DO_H, (const char*)(ws + WS_WIN)};
        EpiIn E{(bf16_t*)(ws + WS_U), (bf16_t*)(ws + WS_KVC), (const float*)(ws + WS_ROPE), (const float*)(ws + WS_ROPE) + 2048 * 32};
        pg8::gemm_phase<EpiIn, SchedIn, true, false>(lds, 1024, S, E);
        SEAM(2);
    }
    if (IN(3)) { p3_attn_conv(args, (char*)lds_raw, tid); SEAM(3); }
    if (IN(4)) {
        SchedZ S{G, (int)blockIdx.x, (const char*)args.out + DO_A1, (const char*)args.out + DO_O, (const char*)(ws + WS_WA), (const char*)(ws + WS_WB)};
        EpiZ E{(const bf16_t*)(ws + WS_U), (bf16_t*)(ws + WS_Z)};
        pg8::gemm_phase<EpiZ, SchedZ, false, false>(lds, 512, S, E);
        SEAM(4);
    }
    if (IN(5)) {
        SchedDense S{G, (int)blockIdx.x, 64, 4, (const char*)(ws + WS_Z), (const char*)(ws + WS_WO), (size_t)256 * 1024 * 2};
        EpiX1 E{args.x, (const float*)(ws + WS_MOD), args.out};
        pg8::gemm_phase<EpiX1, SchedDense, false, false>(lds, 1024, S, E);
        SEAM(5);
    }
    if (IN(6)) { p5_norm2_route(args, lds, tid, lane, wave); SEAM(6); }
    if (IN(7)) {
        const int T = moe_tables(args, lds, tid);
        SchedMoe S{G, (int)blockIdx.x, 2, 2 * T, (const LAS int*)(lds + MISC_OFF + 256) + 32, (const LAS int*)(lds + MISC_OFF + 256), (const char*)(ws + WS_H2), (const char*)(ws + WS_WUP), 0, (size_t)512 * 1024 * 2, (size_t)256 * 1024 * 2, (const i32x2*)(ws + WS_LIST)};
        EpiUp E{(bf16_t*)(ws + WS_ACT)};
        pg8::gemm_phase<EpiUp, SchedMoe, true, true>(lds, 1024, S, E);
        SEAM(7);
    }
    if (IN(8)) {
        const int T = moe_tables(args, lds, tid);
        SchedMoe S{G, (int)blockIdx.x, 4, 4 * T, (const LAS int*)(lds + MISC_OFF + 256) + 32, (const LAS int*)(lds + MISC_OFF + 256), (const char*)(ws + WS_ACT), (const char*)(ws + WS_WDN), (size_t)256 * 256 * 2, (size_t)1024 * 256 * 2, (size_t)256 * 256 * 2, (const i32x2*)(ws + WS_LIST)};
        EpiDown E{(bf16_t*)(ws + WS_Y0), (bf16_t*)(ws + WS_DUMP) + (size_t)blockIdx.x * 1024, (const i32x2*)(ws + WS_LIST), (const LAS int*)(lds + MISC_OFF + 256)};
        pg8::gemm_phase<EpiDown, SchedMoe, true, false>(lds, 256, S, E);
        SEAM(8);
    }
    if (IN(9)) { p9_final(args, lane, wave); }
#undef IN
#undef SEAM
}

extern "C" void kernel_launch(void* const* d_in, const int* in_sizes, int n_in, void* d_out, int out_size, void* d_ws, size_t ws_size, hipStream_t stream) {
    static int grid = 0;
    if (grid == 0) {
        if (n_in != 22 || out_size != MLAT * DM || ws_size < WS_END) { fprintf(stderr, "kernel_launch: unexpected problem (n_in %d, out %d, ws %zu)\n", n_in, out_size, ws_size); grid = -1; return; }
        int dev = 0, cus = 0, per_cu = 0;
        if (hipGetDevice(&dev) != hipSuccess || hipDeviceGetAttribute(&cus, hipDeviceAttributeMultiprocessorCount, dev) != hipSuccess) { grid = -1; return; }
        if (hipFuncSetAttribute((const void*)fwd_kernel, hipFuncAttributeMaxDynamicSharedMemorySize, LDS_BYTES) != hipSuccess) { fprintf(stderr, "kernel_launch: hipFuncSetAttribute failed\n"); grid = -1; return; }
        if (hipOccupancyMaxActiveBlocksPerMultiprocessor(&per_cu, (const void*)fwd_kernel, 512, LDS_BYTES) != hipSuccess || per_cu < 1) { fprintf(stderr, "kernel_launch: occupancy query says %d\n", per_cu); (void)hipGetLastError(); per_cu = 1; }
        grid = cus;
        if (grid > 256) grid = 256;
    }
    if (grid < 0) return;
    (void)hipMemsetAsync((char*)d_ws + WS_CTL, 0, CTL_ZERO_BYTES, stream);
    Args a{};
    const float** p = (const float**)&a;
    for (int i = 0; i < 22; ++i) p[i] = (const float*)d_in[i];
    a.out = (float*)d_out; a.ws = (unsigned char*)d_ws;
#if MK_N_LAUNCHES == 1
    a.ph_lo = 0; a.ph_hi = NPHASE;
    void* kargs[] = {&a};
    hipError_t e = hipLaunchCooperativeKernel((const void*)fwd_kernel, dim3(grid), dim3(512), kargs, LDS_BYTES, stream);
    if (e != hipSuccess) fprintf(stderr, "cooperative launch failed: %s (grid %d)\n", hipGetErrorString(e), grid);
#else
    for (int ph = 0; ph < NPHASE; ++ph) { a.ph_lo = ph; a.ph_hi = ph + 1; hipLaunchKernelGGL(fwd_kernel, dim3(grid), dim3(512), LDS_BYTES, stream, a); }
#endif
}
```

```cpp
#include <hip/hip_runtime.h>
#include <hip/hip_cooperative_groups.h>
#include <cstdio>
#include <cstdint>
namespace cg = cooperative_groups;

#ifndef MK_N_LAUNCHES
#define MK_N_LAUNCHES 1
#endif

#define LAS __attribute__((address_space(3)))
#define GAS __attribute__((address_space(1)))
typedef unsigned short bf16_t;
typedef short bf16x8 __attribute__((ext_vector_type(8)));
typedef short s16x4 __attribute__((ext_vector_type(4)));
typedef float f32x2 __attribute__((ext_vector_type(2)));
typedef float f32x4 __attribute__((ext_vector_type(4)));
typedef float f32x16 __attribute__((ext_vector_type(16)));
typedef unsigned u32x2 __attribute__((ext_vector_type(2)));
typedef unsigned u32x4 __attribute__((ext_vector_type(4)));
typedef int i32x2 __attribute__((ext_vector_type(2)));

constexpr int DM = 1024, NBATCH = 8, SEQ = 2048, MLAT = NBATCH * SEQ, CTXL = 256, MCTX = NBATCH * CTXL, MALL = MLAT + MCTX;
constexpr int NIN = 4352;
constexpr int C_B = 0, C_CG = 512, C_X = 1024, C_Q = 1536, C_K = 2048, C_V = 2176, C_GA = 2304, C_GB = 3328;
constexpr int NEXP = 32, EFF = 256, LISTCAP = 16384;
constexpr float NORM_EPS = 1e-6f;
constexpr float QSCALE = 0.125f * 1.4426950408889634f;
constexpr float LOG2E = 1.4426950408889634f;
constexpr int NPHASE = 10;

constexpr size_t MiB = 1u << 20;
constexpr size_t WS_CTL = 0, CTL_ZERO_BYTES = 1 * MiB;
constexpr size_t WS_MOD = 1 * MiB;
constexpr size_t WS_ROPE = 1 * MiB + 512 * 1024;
constexpr size_t WS_WR = 2 * MiB;
constexpr size_t WS_LIST = 3 * MiB;
constexpr size_t WS_WIN = 7 * MiB;
constexpr size_t WS_WA = 16 * MiB, WS_WB = 17 * MiB, WS_WO = 18 * MiB;
constexpr size_t WS_WUP = 20 * MiB;
constexpr size_t WS_WDN = 52 * MiB;
constexpr size_t WS_KVC = 68 * MiB;
constexpr size_t WS_Z = 70 * MiB;
constexpr size_t WS_U = 102 * MiB;
constexpr size_t WS_H2 = 102 * MiB, WS_Y0 = 134 * MiB, WS_Y1 = 166 * MiB, WS_ACT = 198 * MiB;
constexpr size_t WS_DUMP = 238 * MiB;
constexpr size_t WS_END = 239 * MiB;
constexpr size_t DO_H = 0, DO_A1 = 0, DO_O = 16 * MiB;
constexpr int CW_CNT = 1024;
constexpr int CW_BAR = 4096;

constexpr int RING_BYTES = 131072;
constexpr int MISC_OFF = RING_BYTES;
constexpr int LDS_BYTES = 147456;

#define LDS_WAIT() asm volatile("s_waitcnt lgkmcnt(0)" ::: "memory")
#define VM_WAIT() asm volatile("s_waitcnt vmcnt(0)" ::: "memory")

__device__ __forceinline__ unsigned f2bf(float f) { unsigned u = __builtin_bit_cast(unsigned, f); return (u + 0x7fffu + ((u >> 16) & 1u)) >> 16; }
__device__ __forceinline__ unsigned pk2(float lo, float hi) { return f2bf(lo) | (f2bf(hi) << 16); }
__device__ __forceinline__ float bf2f(unsigned short h) { return __builtin_bit_cast(float, (unsigned)h << 16); }
__device__ __forceinline__ float bflo(unsigned w) { return __builtin_bit_cast(float, w << 16); }
__device__ __forceinline__ float bfhi(unsigned w) { return __builtin_bit_cast(float, w & 0xffff0000u); }
__device__ __forceinline__ unsigned cvt_pk_bf16(float lo, float hi) { unsigned r; asm volatile("v_cvt_pk_bf16_f32 %0, %1, %2" : "=v"(r) : "v"(lo), "v"(hi)); return r; }
__device__ __forceinline__ float wave_sum(float v) {
#pragma unroll
    for (int o = 1; o < 64; o <<= 1) v += __shfl_xor(v, o);
    return v;
}
__device__ __forceinline__ float enegf_(float g) { g = fminf(fmaxf(g, -30.f), 30.f); return __expf(-g); }
__device__ __forceinline__ float sigmoidf_(float g) { return __builtin_amdgcn_rcpf(1.0f + enegf_(g)); }

namespace pg8 {
constexpr int BM = 256, BK = 64, HALF = 128, HTB = HALF * BK * 2, STAGE_BYTES = 8 * HTB, NXCD = 8, WGM = 8;
__host__ __device__ __forceinline__ int lds_byte(int r, int c) { const int st = (r >> 4) * 2 + (c >> 5), rr = r & 15, cc = c & 31, ob = rr * 64 + cc * 2; return st * 1024 + (ob ^ (((ob >> 9) & 1) << 5)); }
__host__ __device__ __forceinline__ void stage_rc(int b, int& R, int& C) { const int st = b / 1024, sb = b % 1024, swz = sb ^ (((sb >> 9) & 1) << 5); R = (st >> 1) * 16 + swz / 64; C = (st & 1) * 32 + (swz % 64) / 2; }
__host__ __device__ __forceinline__ int perm32(int rho) { const int n = rho >> 4, i = rho & 15; return 8 * (i >> 2) + 4 * n + (i & 3); }

struct Unit { int pm, pn, aux; };
__device__ __forceinline__ void static_map(int nM, int nN, int L, int& pm, int& pn) {
    const int nwg = nM * nN; int wgid = L;
    { const int q = nwg / NXCD, r = nwg % NXCD, xcd = wgid % NXCD, off = wgid / NXCD; wgid = (xcd < r ? xcd * (q + 1) : r * (q + 1) + (xcd - r) * q) + off; }
    const int nig = WGM * nN, gid = wgid / nig, fm = gid * WGM, gsz = (nM - fm) < WGM ? (nM - fm) : WGM;
    pm = fm + ((wgid % nig) % gsz); pn = (wgid % nig) / gsz;
}
typedef f32x4 Acc[2][2][4][2];

template <class Epi, class Sched, bool ALIGN_EPI, bool GATHER>
__device__ __forceinline__ void gemm_phase(LAS unsigned char* lds, const int K, const Sched& S, const Epi& E) {
    const int tid = threadIdx.x, wid = __builtin_amdgcn_readfirstlane(tid >> 6), lane = tid & 63, wr = wid >> 2, wc = wid & 3, fr = lane & 15, fq = lane >> 4;
    const int nt = K / BK;
    int stR[2], stC[2];
    unsigned voffB[2], vA0[2], vA1[2], nA0[2], nA1[2];
    const size_t kstep = (size_t)(BK * 2);
    const size_t hstep = (size_t)HALF * K * 2;
#pragma unroll
    for (int i = 0; i < 2; ++i) { int R, C; stage_rc(tid * 16 + i * 8192, R, C); const int Rb = Epi::PERM ? ((R & ~31) + perm32(R & 31)) : R;
        stR[i] = R; stC[i] = C; voffB[i] = (unsigned)(Rb * K + C) * 2u; vA0[i] = (unsigned)(R * K + C) * 2u; vA1[i] = vA0[i] + (unsigned)hstep; nA0[i] = vA0[i]; nA1[i] = vA1[i]; }
    const unsigned ldsw = (unsigned)wid * 1024u;
    const int aoff = lds_byte(wr * 64 + fr, fq * 8), boff = lds_byte(wc * 32 + fr, fq * 8);
#define PG8_SA(b, h) (((b) * 2 + (h)) * HTB)
#define PG8_SB(b, h) ((4 + (b) * 2 + (h)) * HTB)
#define PG8_STAGE(bufoff, gbase, voff) do { _Pragma("unroll") for (int _i = 0; _i < 2; ++_i) \
        __builtin_amdgcn_global_load_lds((const unsigned*)((const char*)(gbase) + (voff)[_i]), (LAS unsigned*)(lds + (bufoff) + ldsw + _i * 8192), 16, 0, 0); } while (0)
#define PG8_LDA(dst, b, h) do { _Pragma("unroll") for (int m = 0; m < 4; ++m) _Pragma("unroll") for (int k = 0; k < 2; ++k) dst[m][k] = *(const LAS bf16x8*)(lds + PG8_SA(b, h) + aoff + m * 2048 + k * 1024); } while (0)
#define PG8_LDB(dst, b, h) do { _Pragma("unroll") for (int n = 0; n < 2; ++n) _Pragma("unroll") for (int k = 0; k < 2; ++k) dst[n][k] = *(const LAS bf16x8*)(lds + PG8_SB(b, h) + boff + n * 2048 + k * 1024); } while (0)
#define PG8_MMA(ai, bj, At, Bt) do { __builtin_amdgcn_s_setprio(1); _Pragma("unroll") for (int m = 0; m < 4; ++m) _Pragma("unroll") for (int n = 0; n < 2; ++n) _Pragma("unroll") for (int k = 0; k < 2; ++k) \
        acc[ai][bj][m][n] = __builtin_amdgcn_mfma_f32_16x16x32_bf16(Bt[n][k], At[m][k], acc[ai][bj][m][n], 0, 0, 0); __builtin_amdgcn_s_setprio(0); } while (0)
#define PG8_WAIT_V(n) asm volatile("s_waitcnt vmcnt(" #n ")" ::: "memory")
#define PG8_WAIT_L(n) asm volatile("s_waitcnt lgkmcnt(" #n ")" ::: "memory")
#define PG8_BAR __builtin_amdgcn_s_barrier()
#define PG8_SCHED __builtin_amdgcn_sched_barrier(0)
    Unit cur, nxt; int ui = 0;
    if (!S.next(0, cur)) return;
    Acc acc;
#pragma unroll
    for (int a = 0; a < 2; ++a)
#pragma unroll
        for (int b = 0; b < 2; ++b)
#pragma unroll
            for (int m = 0; m < 4; ++m)
#pragma unroll
                for (int n = 0; n < 2; ++n) acc[a][b][m][n] = (f32x4){0.f, 0.f, 0.f, 0.f};
    bf16x8 At[4][2], B0[2][2], B1[2][2];
    const char* cA = S.abase(cur); const char* cB = S.bbase(cur);
    if constexpr (GATHER) {
#pragma unroll
        for (int i = 0; i < 2; ++i) { vA0[i] = (unsigned)(S.arow(cur, stR[i]) * K + stC[i]) * 2u; vA1[i] = (unsigned)(S.arow(cur, HALF + stR[i]) * K + stC[i]) * 2u; }
    }
    PG8_STAGE(PG8_SB(0, 0), cB, voffB); PG8_STAGE(PG8_SB(0, 1), cB + hstep, voffB); PG8_STAGE(PG8_SA(0, 0), cA, vA0); PG8_STAGE(PG8_SA(0, 1), cA, vA1);
    if (wr == 1) PG8_BAR;
    PG8_WAIT_V(2); PG8_BAR;
    PG8_STAGE(PG8_SB(1, 0), cB + kstep, voffB); PG8_STAGE(PG8_SA(1, 0), cA + kstep, vA0); PG8_STAGE(PG8_SB(1, 1), cB + hstep + kstep, voffB);
    PG8_WAIT_V(6); PG8_BAR;
    for (;;) {
        const bool has_next = S.next(ui + 1, nxt);
        const char* nA = has_next ? S.abase(nxt) : cA; const char* nB = has_next ? S.bbase(nxt) : cB;
        if constexpr (GATHER) {
            if (has_next) {
#pragma unroll
                for (int i = 0; i < 2; ++i) { nA0[i] = (unsigned)(S.arow(nxt, stR[i]) * K + stC[i]) * 2u; nA1[i] = (unsigned)(S.arow(nxt, HALF + stR[i]) * K + stC[i]) * 2u; }
            } else {
#pragma unroll
                for (int i = 0; i < 2; ++i) { nA0[i] = vA0[i]; nA1[i] = vA1[i]; }
            }
        }
#pragma unroll 1
        for (int t = 0; t < nt; t += 2) {
            const bool last = (t == nt - 2);
            const char* a1 = cA + (size_t)(t + 1) * kstep;
            const char* a2 = last ? nA : cA + (size_t)(t + 2) * kstep; const char* b2 = last ? nB : cB + (size_t)(t + 2) * kstep;
            const char* a3 = a2 + kstep; const char* b3 = b2 + kstep;
            unsigned xA0[2], xA1[2];
#pragma unroll
            for (int i = 0; i < 2; ++i) { xA0[i] = (GATHER && last) ? nA0[i] : vA0[i]; xA1[i] = (GATHER && last) ? nA1[i] : vA1[i]; }
            PG8_LDB(B0, 0, 0); PG8_LDB(B1, 0, 1); PG8_SCHED; PG8_LDA(At, 0, 0); PG8_STAGE(PG8_SA(1, 1), a1, vA1);
            PG8_WAIT_V(8); PG8_WAIT_L(0); PG8_BAR; PG8_MMA(0, 0, At, B0); PG8_MMA(0, 1, At, B1); PG8_BAR; PG8_SCHED;
            PG8_LDA(At, 0, 1); PG8_STAGE(PG8_SB(0, 0), b2, voffB); PG8_STAGE(PG8_SB(0, 1), b2 + hstep, voffB); PG8_STAGE(PG8_SA(0, 0), a2, xA0);
            PG8_WAIT_V(8); PG8_WAIT_L(0); PG8_BAR; PG8_MMA(1, 0, At, B0); PG8_MMA(1, 1, At, B1); PG8_BAR; PG8_SCHED;
            PG8_LDB(B0, 1, 0); PG8_LDB(B1, 1, 1); PG8_SCHED; PG8_LDA(At, 1, 0); PG8_STAGE(PG8_SA(0, 1), a2, xA1);
            PG8_WAIT_V(8); PG8_WAIT_L(0); PG8_BAR; PG8_MMA(0, 0, At, B0); PG8_MMA(0, 1, At, B1); PG8_BAR; PG8_SCHED;
            PG8_LDA(At, 1, 1); PG8_STAGE(PG8_SB(1, 0), b3, voffB); PG8_STAGE(PG8_SB(1, 1), b3 + hstep, voffB); PG8_STAGE(PG8_SA(1, 0), a3, xA0);
            PG8_WAIT_V(8); PG8_WAIT_L(0); PG8_BAR; PG8_MMA(1, 0, At, B0); PG8_MMA(1, 1, At, B1); PG8_BAR; PG8_SCHED;
        }
        if constexpr (ALIGN_EPI) { if (wr == 0) PG8_BAR; }
        const bool keep = E(acc, cur, wr, wc, fr, fq);
        if (!has_next) break;
        if (!keep) {
#pragma unroll
            for (int a = 0; a < 2; ++a)
#pragma unroll
                for (int b = 0; b < 2; ++b)
#pragma unroll
                    for (int m = 0; m < 4; ++m)
#pragma unroll
                        for (int n = 0; n < 2; ++n) acc[a][b][m][n] = (f32x4){0.f, 0.f, 0.f, 0.f};
        }
        cur = nxt; cA = nA; cB = nB; ++ui;
        if constexpr (GATHER) {
#pragma unroll
            for (int i = 0; i < 2; ++i) { vA0[i] = nA0[i]; vA1[i] = nA1[i]; }
        }
        if constexpr (ALIGN_EPI) { if (wr == 1) PG8_BAR; }
    }
    PG8_WAIT_V(0);
    if constexpr (!ALIGN_EPI) { if (wr == 0) PG8_BAR; }
    PG8_BAR;
#undef PG8_SA
#undef PG8_SB
#undef PG8_STAGE
#undef PG8_LDA
#undef PG8_LDB
#undef PG8_MMA
#undef PG8_WAIT_V
#undef PG8_WAIT_L
#undef PG8_BAR
#undef PG8_SCHED
}
}

#define XB_TMO      128
#define XB_XCNT(j)  (256  + 64 * (j))
#define XB_XSUB(j)  (1280 + 64 * (j))
#define XB_XGEN(j)  (2304 + 64 * (j))
#define XB_TOP      3328
#define XB_TOPGEN   3392
#define XCD_BAR_WORDS 3456
#define XB_SPIN_CAP (1u << 18)
__device__ __forceinline__ unsigned xb_ld(unsigned* p)              { return __hip_atomic_load(p, __ATOMIC_RELAXED, __HIP_MEMORY_SCOPE_AGENT); }
__device__ __forceinline__ unsigned xb_add(unsigned* p, unsigned v) { return __hip_atomic_fetch_add(p, v, __ATOMIC_RELAXED, __HIP_MEMORY_SCOPE_AGENT); }
__device__ __forceinline__ unsigned xb_xcc_id() { return (unsigned)__builtin_amdgcn_s_getreg((3 << 11) | 20) & 0xFu; }
#define XB_SPIN(cond, bar) do { unsigned _sp = 0; while (cond) { __builtin_amdgcn_s_sleep(1); \
    if ((++_sp & 255u) == 0u) { if (xb_ld(&(bar)[XB_TMO])) break; if (_sp > XB_SPIN_CAP) { atomicAdd(&(bar)[XB_TMO], 1u); break; } } } } while (0)
struct XcdBarrier { unsigned* bar; unsigned x; volatile LAS unsigned* st; };
__device__ __forceinline__ XcdBarrier xcd_barrier_post(unsigned* bar, volatile LAS unsigned* st) {
    XcdBarrier b; b.bar = bar; b.x = xb_xcc_id(); b.st = st;
    if (threadIdx.x == 0) (void)xb_add(&bar[XB_XCNT(b.x)], 1u);
    return b;
}
__device__ __forceinline__ void xcd_barrier_complete(unsigned* bar, unsigned x, unsigned& nloc, unsigned& nx) {
    const unsigned G = gridDim.x * gridDim.y * gridDim.z;
    unsigned sum, cnt, mine, sp = 0u;
    for (;;) {
        sum = 0u; cnt = 0u; mine = 0u;
#pragma unroll
        for (unsigned j = 0; j < 16; ++j) { const unsigned c = xb_ld(&bar[XB_XCNT(j)]); sum += c; cnt += (c > 0u) ? 1u : 0u; mine = (j == x) ? c : mine; }
        if (sum == G) break;
        __builtin_amdgcn_s_sleep(1);
        if ((++sp & 255u) == 0u) { if (xb_ld(&bar[XB_TMO])) break; if (sp > XB_SPIN_CAP) { atomicAdd(&bar[XB_TMO], 1u); break; } }
    }
    nloc = mine > 0u ? mine : 1u; nx = cnt > 0u ? cnt : 1u;
}
__device__ __forceinline__ void xcd_barrier(const XcdBarrier& b) {
    asm volatile("s_waitcnt vmcnt(0)" ::: "memory");
    __syncthreads();
    if (threadIdx.x == 0) {
        unsigned* bar = b.bar;
        __builtin_amdgcn_s_waitcnt(0);
        unsigned nloc = b.st[0], nx = b.st[1];
        if (nloc == 0u) { xcd_barrier_complete(bar, b.x, nloc, nx); b.st[0] = nloc; b.st[1] = nx; }
        const unsigned old = xb_add(&bar[XB_XSUB(b.x)], 1u);
        const unsigned gen = old / nloc;
        if (old + 1u == (gen + 1u) * nloc) {
            __builtin_amdgcn_fence(__ATOMIC_RELEASE, "agent");
            asm volatile("s_waitcnt vmcnt(0)" ::: "memory");
            const unsigned og = xb_add(&bar[XB_TOP], 1u);
            const unsigned tg = og / nx;
            if (og + 1u == (tg + 1u) * nx) xb_add(&bar[XB_TOPGEN], 1u);
            else XB_SPIN(xb_ld(&bar[XB_TOPGEN]) == tg, bar);
            __builtin_amdgcn_fence(__ATOMIC_ACQUIRE, "agent");
            xb_add(&bar[XB_XGEN(b.x)], 1u);
            asm volatile("s_waitcnt vmcnt(0)" ::: "memory");
        } else {
            XB_SPIN(xb_ld(&bar[XB_XGEN(b.x)]) == gen, bar);
            __builtin_amdgcn_fence(__ATOMIC_ACQUIRE, "agent");
            asm volatile("s_waitcnt vmcnt(0)" ::: "memory");
        }
    }
    __syncthreads();
}

struct Args {
    const float *x, *c, *ctx, *c_ctx, *w_ada, *b_ada, *norm1_g, *w_in, *w_conv, *b_conv, *w_a, *w_b, *sink, *w_o, *norm2_g, *w_group, *b_group, *w_router, *b_router, *w_up, *w_down, *final_g;
    float* out; unsigned char* ws; int ph_lo, ph_hi;
};

__device__ const float ROPE_INV[16] = {1.0f, 0.5623413251903491f, 0.31622776601683794f, 0.1778279410038923f, 0.1f, 0.05623413251903491f, 0.031622776601683794f, 0.01778279410038923f,
                                       0.01f, 0.005623413251903491f, 0.0031622776601683794f, 0.001778279410038923f, 0.001f, 5.623413251903491e-4f, 3.1622776601683794e-4f, 1.778279410038923e-4f};
__device__ __forceinline__ void sincos_acc(float angf, float& s, float& c) {
    const double TWO_PI = 6.283185307179586476925;
    double a = (double)angf; const double k = __builtin_rint(a / TWO_PI); const double r = a - k * TWO_PI, r2 = r * r;
    double cs = 1.0, sn = 1.0;
#pragma unroll
    for (int n = 12; n >= 1; --n) { cs = 1.0 - cs * r2 / (double)((2 * n - 1) * (2 * n)); sn = 1.0 - sn * r2 / (double)((2 * n) * (2 * n + 1)); }
    s = (float)(sn * r); c = (float)cs;
}

template <class SrcMap>
__device__ __forceinline__ void transpose_item(const float* W, int K, int N, bf16_t* WT, LAS float* scr, int item, int lane, const SrcMap& src) {
    const int nblk = N / 32, kb = item / nblk, nb = item % nblk, k0 = 64 * kb, n0 = 32 * nb;
    const int sc = src(n0 + (lane & 31));
#pragma unroll 8
    for (int i = 0; i < 32; ++i) { const int kk = 2 * i + (lane >> 5); scr[kk * 33 + (lane & 31)] = W[(size_t)(k0 + kk) * N + sc]; }
    LDS_WAIT(); asm volatile("" ::: "memory");
    const int c = lane & 7;
#pragma unroll
    for (int j = 0; j < 4; ++j) { const int n = (lane >> 3) + 8 * j; const LAS float* s = scr + (8 * c) * 33 + n;
        u32x4 o; o.x = pk2(s[0 * 33], s[1 * 33]); o.y = pk2(s[2 * 33], s[3 * 33]); o.z = pk2(s[4 * 33], s[5 * 33]); o.w = pk2(s[6 * 33], s[7 * 33]);
        *(GAS u32x4*)(WT + (size_t)(n0 + n) * K + k0 + 8 * c) = o; }
    LDS_WAIT(); asm volatile("" ::: "memory");
}
struct MapId { __device__ __forceinline__ int operator()(int r) const { return r; } };
struct MapIn { __device__ __forceinline__ int operator()(int r) const { if (r >= C_Q && r < C_V) { const int p = r & 63; return (r & ~63) + 4 * (p >> 3) + (p & 3) + 32 * ((p >> 2) & 1); } return r; } };
struct MapUp { __device__ __forceinline__ int operator()(int r) const { const int pn = r >> 8, p = r & 255; return 128 * pn + 4 * (p >> 3) + (p & 3) + 256 * ((p >> 2) & 1); } };

__device__ __forceinline__ void p0_prologue(const Args& a, LAS unsigned char* lds, int tid, int lane, int wave) {
    unsigned char* ws = a.ws;
    const int G = gridDim.x;
    {
        LAS float* S = (LAS float*)lds;
        LAS float* R = (LAS float*)(lds + 36864);
        float* mod = (float*)(ws + WS_MOD);
        bool have = false;
        for (int task = blockIdx.x; task < 192; task += G) {
            if (!have) {
                for (int idx = tid; idx < 9 * 1024; idx += 512) { const int b = idx >> 10, k = idx & 1023; const float v = (b < 8) ? a.c[b * 1024 + k] : a.c_ctx[k]; S[idx] = v / (1.0f + __expf(-v)); }
                have = true;
            }
            __syncthreads();
            const int c4 = tid & 7, kr = tid >> 3;
            f32x4 acc[9];
#pragma unroll
            for (int b = 0; b < 9; ++b) acc[b] = (f32x4){0.f, 0.f, 0.f, 0.f};
            const float* wp = a.w_ada + (size_t)kr * 6144 + 32 * task + 4 * c4;
#pragma unroll 4
            for (int it = 0; it < 16; ++it) { const f32x4 w = *(const f32x4*)(wp + (size_t)it * 64 * 6144); const int k = kr + 64 * it;
#pragma unroll
                for (int b = 0; b < 9; ++b) acc[b] += S[b * 1024 + k] * w; }
#pragma unroll
            for (int b = 0; b < 9; ++b) *(LAS f32x4*)(R + (kr * 9 + b) * 32 + 4 * c4) = acc[b];
            __syncthreads();
            if (tid < 288) { const int b = tid >> 5, col = tid & 31; float s = 0.f;
                for (int k2 = 0; k2 < 64; ++k2) s += R[(k2 * 9 + b) * 32 + col];
                mod[b * 6144 + 32 * task + col] = s + a.b_ada[32 * task + col]; }
            __syncthreads();
        }
        __syncthreads();
    }
    {
        float* cosT = (float*)(ws + WS_ROPE); float* sinT = cosT + 2048 * 32;
        for (int idx = blockIdx.x * 512 + tid; idx < 2048 * 32; idx += G * 512) { const int t = idx >> 5, i = idx & 31;
            const float pos = (i < 16) ? (float)(t >> 6) : (float)(t & 63); const float ang = pos * ROPE_INV[i & 15]; float s, c; sincos_acc(ang, s, c); cosT[idx] = c; sinT[idx] = s; }
        bf16_t* wrh = (bf16_t*)(ws + WS_WR); bf16_t* wrl = wrh + 48 * 1024;
        for (int idx = blockIdx.x * 512 + tid; idx < 48 * 1024; idx += G * 512) { const int n = idx >> 10, k = idx & 1023;
            float v = 0.f; if (n < 4) v = a.w_group[k * 4 + n]; else if (n < 36) v = a.w_router[k * 32 + (n - 4)];
            const unsigned h = f2bf(v); const float rem = v - bf2f((unsigned short)h); wrh[idx] = (bf16_t)h; wrl[idx] = (bf16_t)f2bf(rem); }
    }
    {
        LAS float* scr = (LAS float*)(lds + wave * 16384);
        const int gw = blockIdx.x * 8 + wave, NGW = G * 8;
        constexpr int I_IN = 16 * 136, I_A = 8 * 32, I_O = 16 * 32, I_UP = 16 * 16, I_DN = 4 * 32;
        constexpr int NITEMS = I_IN + 2 * I_A + I_O + 32 * I_UP + 32 * I_DN;
        for (int it = gw; it < NITEMS; it += NGW) {
            int r = it;
            if (r < I_IN) { transpose_item(a.w_in, 1024, NIN, (bf16_t*)(ws + WS_WIN), scr, r, lane, MapIn()); continue; } r -= I_IN;
            if (r < I_A) { transpose_item(a.w_a, 512, 1024, (bf16_t*)(ws + WS_WA), scr, r, lane, MapId()); continue; } r -= I_A;
            if (r < I_A) { transpose_item(a.w_b, 512, 1024, (bf16_t*)(ws + WS_WB), scr, r, lane, MapId()); continue; } r -= I_A;
            if (r < I_O) { transpose_item(a.w_o, 1024, 1024, (bf16_t*)(ws + WS_WO), scr, r, lane, MapId()); continue; } r -= I_O;
            if (r < 32 * I_UP) { const int e = r / I_UP; transpose_item(a.w_up + (size_t)e * 1024 * 512, 1024, 512, (bf16_t*)(ws + WS_WUP) + (size_t)e * 512 * 1024, scr, r % I_UP, lane, MapUp()); continue; } r -= 32 * I_UP;
            { const int e = r / I_DN; transpose_item(a.w_down + (size_t)e * 256 * 1024, 256, 1024, (bf16_t*)(ws + WS_WDN) + (size_t)e * 1024 * 256, scr, r % I_DN, lane, MapId()); }
        }
    }
}

__device__ __forceinline__ void p1_norm1(const Args& a, int lane, int wave) {
    const float* mod = (const float*)(a.ws + WS_MOD);
    bf16_t* H = (bf16_t*)((unsigned char*)a.out + DO_H);
    const int gw = blockIdx.x * 8 + wave, NGW = gridDim.x * 8;
    const int rpw = (MALL + NGW - 1) / NGW;
    const int r0 = gw * rpw, r1 = (r0 + rpw < MALL) ? r0 + rpw : MALL;
    int curb = -1; f32x4 A[4], B[4];
#pragma unroll
    for (int j = 0; j < 4; ++j) { A[j] = (f32x4){0.f, 0.f, 0.f, 0.f}; B[j] = A[j]; }
    for (int m = r0; m < r1; ++m) {
        const int b = (m < MLAT) ? (m >> 11) : 8;
        if (b != curb) { curb = b;
#pragma unroll
            for (int j = 0; j < 4; ++j) { const int idx = 4 * lane + 256 * j; const f32x4 g = *(const f32x4*)(a.norm1_g + idx), sc = *(const f32x4*)(mod + b * 6144 + 1024 + idx); A[j] = g * (1.0f + sc); B[j] = *(const f32x4*)(mod + b * 6144 + idx); } }
        const float* xr = (m < MLAT) ? a.x + (size_t)m * DM : a.ctx + (size_t)(m - MLAT) * DM;
        f32x4 v[4]; float s = 0.f;
#pragma unroll
        for (int j = 0; j < 4; ++j) { v[j] = *(const f32x4*)(xr + 4 * lane + 256 * j); s += (v[j].x * v[j].x + v[j].y * v[j].y) + (v[j].z * v[j].z + v[j].w * v[j].w); }
        const float inv = 1.0f / sqrtf(wave_sum(s) * (1.0f / DM) + NORM_EPS);
        bf16_t* orow = H + (size_t)m * DM;
#pragma unroll
        for (int j = 0; j < 4; ++j) { const f32x4 h = (v[j] * inv) * A[j] + B[j]; u32x2 w; w.x = pk2(h.x, h.y); w.y = pk2(h.z, h.w); *(u32x2*)(orow + 4 * lane + 256 * j) = w; }
    }
}

struct SchedIn {
    int G, c; const char* A; const char* Bt;
    __device__ __forceinline__ bool next(int i, pg8::Unit& u) const {
        const long L = (long)i * G + c; constexpr int NW = 64 * 17;
        if (L >= NW + 8) return false;
        if (L >= NW) { u.pm = 64 + (int)(L - NW); u.pn = 8; u.aux = 1; return true; }
        pg8::static_map(64, 17, (int)L, u.pm, u.pn); u.aux = 0; return true;
    }
    __device__ __forceinline__ const char* abase(const pg8::Unit& u) const { return A + (size_t)u.pm * (256 * 1024 * 2); }
    __device__ __forceinline__ const char* bbase(const pg8::Unit& u) const { return Bt + (size_t)u.pn * (256 * 1024 * 2); }
    __device__ __forceinline__ int arow(const pg8::Unit&, int) const { return 0; }
};
struct EpiIn {
    static constexpr bool PERM = true;
    bf16_t* U; bf16_t* KVC; const float* cosT; const float* sinT;
    __device__ __forceinline__ bool operator()(pg8::Acc& acc, const pg8::Unit& u, int wr, int wc, int fr, int fq) const {
        const bool isctx = u.aux != 0;
        const int row0 = (isctx ? (u.pm - 64) : u.pm) * 256 + wr * 64 + fr;
        bf16_t* base = isctx ? KVC : U; const int ldc = isctx ? 256 : NIN; const int coff = isctx ? -C_K : 0;
        const int pi = 16 * (wc & 1) + 4 * fq;
#pragma unroll
        for (int ai = 0; ai < 2; ++ai)
#pragma unroll
            for (int m = 0; m < 4; ++m) {
                const int row = row0 + ai * 128 + m * 16;
                bf16_t* rowp = base + (size_t)row * ldc + coff;
                f32x4 cs = (f32x4){1.f, 1.f, 1.f, 1.f}, sn = (f32x4){0.f, 0.f, 0.f, 0.f};
                if (!isctx && u.pn >= 6 && u.pn <= 8) { const int t = row & (SEQ - 1); cs = *(const f32x4*)(cosT + t * 32 + pi); sn = *(const f32x4*)(sinT + t * 32 + pi); }
#pragma unroll
                for (int bj = 0; bj < 2; ++bj) {
                    const int c0 = u.pn * 256 + bj * 128 + wc * 32 + 8 * fq;
                    const f32x4 v0 = acc[ai][bj][m][0], v1 = acc[ai][bj][m][1];
                    const bool rot = (u.pn == 6) || (u.pn == 7) || (u.pn == 8 && bj == 0);
                    if (rot) {
                        const float sc = (u.pn == 8) ? 1.0f : QSCALE;
                        const f32x4 o1 = (v0 * cs - v1 * sn) * sc, o2 = (v0 * sn + v1 * cs) * sc;
                        const int hb = c0 & ~63, f0 = 4 * ((c0 & 63) >> 3);
                        u32x2 w1, w2; w1.x = cvt_pk_bf16(o1[0], o1[1]); w1.y = cvt_pk_bf16(o1[2], o1[3]); w2.x = cvt_pk_bf16(o2[0], o2[1]); w2.y = cvt_pk_bf16(o2[2], o2[3]);
                        *(u32x2*)(rowp + hb + f0) = w1; *(u32x2*)(rowp + hb + f0 + 32) = w2;
                    } else {
                        u32x4 w; w.x = cvt_pk_bf16(v0[0], v0[1]); w.y = cvt_pk_bf16(v0[2], v0[3]); w.z = cvt_pk_bf16(v1[0], v1[1]); w.w = cvt_pk_bf16(v1[2], v1[3]);
                        *(u32x4*)(rowp + c0) = w;
                    }
                }
            }
        return false;
    }
};

namespace att {
constexpr int NSLOT = 3, SLOTB = 8192;
constexpr int LDS_K = 0, LDS_V = NSLOT * SLOTB, LDS_WS = 2 * NSLOT * SLOTB, LDS_OST = LDS_WS + 8 * 64 * 4, LDS_TOTAL = LDS_OST + 8 * 4096;
__device__ __forceinline__ int crow(int r, int hi) { return (r & 3) + 8 * (r >> 2) + 4 * hi; }
__device__ __forceinline__ void glds16(const void* gsrc, unsigned lds_dst) { unsigned keep;
    asm volatile("s_mov_b32 %0, m0\n\ts_mov_b32 m0, %2\n\ts_nop 0\n\tglobal_load_lds_dwordx4 %1, off\n\ts_mov_b32 m0, %0" : "=&s"(keep) : "v"(gsrc), "s"(lds_dst) : "memory"); }
#define ATT_WAIT_BAR(N) asm volatile("s_waitcnt vmcnt(" #N ") lgkmcnt(0)\n\ts_barrier" ::: "memory")
__device__ __forceinline__ void qkt(f32x16& p0, f32x16& p1, const char* Kslot, const bf16x8* qr, int r32, int hi) {
    const char* kb = Kslot + hi * 1024 + r32 * 16;
    const f32x16 z = f32x16{};
#pragma unroll
    for (int d0 = 0; d0 < 4; ++d0) {
        const bf16x8 b0 = *reinterpret_cast<const bf16x8*>(kb + d0 * 2048);
        const bf16x8 b1 = *reinterpret_cast<const bf16x8*>(kb + d0 * 2048 + 512);
        if (d0 == 0) { p0 = __builtin_amdgcn_mfma_f32_32x32x16_bf16(b0, qr[0], z, 0, 0, 0); p1 = __builtin_amdgcn_mfma_f32_32x32x16_bf16(b1, qr[0], z, 0, 0, 0); }
        else { p0 = __builtin_amdgcn_mfma_f32_32x32x16_bf16(b0, qr[d0], p0, 0, 0, 0); p1 = __builtin_amdgcn_mfma_f32_32x32x16_bf16(b1, qr[d0], p1, 0, 0, 0); }
    }
}
__device__ __forceinline__ void pv(f32x16* o, int vb, bf16x8 pa0, bf16x8 pa1, bf16x8 pa2, bf16x8 pa3) {
#pragma unroll
    for (int d0 = 0; d0 < 2; ++d0) { s16x4 lo[4], hi[4];
#pragma unroll
        for (int ks = 0; ks < 4; ++ks) {
            asm volatile("ds_read_b64_tr_b16 %0,%1 offset:%c2" : "=&v"(lo[ks]) : "v"(vb), "i"(d0 * 4096 + ks * 1024) : "memory");
            asm volatile("ds_read_b64_tr_b16 %0,%1 offset:%c2" : "=&v"(hi[ks]) : "v"(vb), "i"(d0 * 4096 + ks * 1024 + 512) : "memory"); }
        asm volatile("s_waitcnt lgkmcnt(0)" ::: "memory"); __builtin_amdgcn_sched_barrier(0);
#define ATT_PK(k) (bf16x8){lo[k][0], lo[k][1], lo[k][2], lo[k][3], hi[k][0], hi[k][1], hi[k][2], hi[k][3]}
        o[d0] = __builtin_amdgcn_mfma_f32_32x32x16_bf16(pa0, ATT_PK(0), o[d0], 0, 0, 0);
        o[d0] = __builtin_amdgcn_mfma_f32_32x32x16_bf16(pa1, ATT_PK(1), o[d0], 0, 0, 0);
        o[d0] = __builtin_amdgcn_mfma_f32_32x32x16_bf16(pa2, ATT_PK(2), o[d0], 0, 0, 0);
        o[d0] = __builtin_amdgcn_mfma_f32_32x32x16_bf16(pa3, ATT_PK(3), o[d0], 0, 0, 0);
#undef ATT_PK
    }
}
__device__ __forceinline__ void attn_unit(int b, int kvh, int qb, int hp, const bf16_t* U, const bf16_t* KVC, bf16_t* O, const float* sink, char* shm) {
    const int tid = threadIdx.x, lane = tid & 63, r32 = lane & 31, hi = lane >> 5; const int wid = __builtin_amdgcn_readfirstlane(tid >> 6);
    const int head = 4 * kvh + 2 * hp + (wid >> 2), qoff = 32 * (wid & 3);
    const size_t qrow0 = (size_t)b * SEQ + qb * 128 + qoff;
    const unsigned lds0 = (unsigned)(uintptr_t)shm;
    float* wsf = (float*)(shm + LDS_WS) + wid * 64;
    const int jlo = (qb == 0) ? 2 : 0, jhi = (qb == SEQ / 128 - 1) ? 4 : 6, nwin = jhi - jlo, NT = nwin + 4;
    const bf16_t* kwin = U + ((size_t)b * SEQ + (size_t)lane) * NIN + C_K + kvh * 64 + wid * 8;
    const bf16_t* vwin = U + ((size_t)b * SEQ + (size_t)(16 * (wid & 3) + (lane >> 2))) * NIN + C_V + kvh * 64 + (wid >> 2) * 32 + (lane & 3) * 8;
    const bf16_t* kctx = KVC + ((size_t)b * CTXL + (size_t)lane) * 256 + kvh * 64 + wid * 8;
    const bf16_t* vctx = KVC + ((size_t)b * CTXL + (size_t)(16 * (wid & 3) + (lane >> 2))) * 256 + 128 + kvh * 64 + (wid >> 2) * 32 + (lane & 3) * 8;
    const unsigned kdst = lds0 + LDS_K + wid * 1024, vdst = lds0 + LDS_V + wid * 1024;
    const int kw0 = qb * 128 - 128 + 64 * jlo;
#define ATT_DMA(t, slot) do { const int t_ = (t); const unsigned so_ = (unsigned)(slot); \
        if (t_ < nwin) { const size_t ro_ = (size_t)(kw0 + 64 * t_) * NIN; glds16(kwin + ro_, (unsigned)__builtin_amdgcn_readfirstlane(kdst + so_)); glds16(vwin + ro_, (unsigned)__builtin_amdgcn_readfirstlane(vdst + so_)); } \
        else { const size_t ro_ = (size_t)(64 * (t_ - nwin)) * 256; glds16(kctx + ro_, (unsigned)__builtin_amdgcn_readfirstlane(kdst + so_)); glds16(vctx + ro_, (unsigned)__builtin_amdgcn_readfirstlane(vdst + so_)); } } while (0)
    const bf16_t* Qw = U + qrow0 * NIN + C_Q + head * 64;
    bf16x8 qr[4];
#pragma unroll
    for (int d0 = 0; d0 < 4; ++d0) qr[d0] = *reinterpret_cast<const bf16x8*>(&Qw[(size_t)r32 * NIN + d0 * 16 + hi * 8]);
    ATT_DMA(0, 0); ATT_DMA(1, SLOTB);
    const float sk = sink[head] * LOG2E;
    float mrun = sk, l_reg = (hi == 0) ? 1.0f : 0.0f;
    f32x16 o[2]; o[0] = f32x16{}; o[1] = f32x16{};
    const int vb0 = (int)(lds0 + LDS_V) + ((lane >> 4) & 1) * 32 + (lane & 3) * 8 + (4 * hi + ((lane & 15) >> 2)) * 64;
    int slot = 0;
    for (int t = 0; t < NT; ++t) {
        if (t + 1 < NT) { ATT_WAIT_BAR(2); } else { ATT_WAIT_BAR(0); }
        if (t + 2 < NT) { const int s2 = (slot >= SLOTB) ? slot - SLOTB : slot + 2 * SLOTB; ATT_DMA(t + 2, s2); }
        bool skip = false; int mbase = 0;
        if (t < nwin) { const int kr0 = 64 * (jlo + t) - 128; skip = (kr0 - (qoff + 31) > 128) || (qoff - (kr0 + 63) > 128); mbase = kr0 - (qoff + r32); }
        if (!skip) {
            f32x16 p0, p1;
            qkt(p0, p1, shm + LDS_K + slot, qr, r32, hi);
            if (t < nwin) {
#pragma unroll
                for (int r = 0; r < 16; ++r) { const int d = mbase + crow(r, hi); if (d < -128 || d > 128) p0[r] = -1e30f; if (d + 32 < -128 || d + 32 > 128) p1[r] = -1e30f; }
            }
            float rm = fmaxf(p0[0], p1[0]);
#pragma unroll
            for (int r = 1; r < 16; ++r) rm = fmaxf(rm, fmaxf(p0[r], p1[r]));
            { auto rr = __builtin_amdgcn_permlane32_swap(__float_as_uint(rm), __float_as_uint(rm), false, false); rm = fmaxf(__uint_as_float(rr[0]), __uint_as_float(rr[1])); }
            const float mn = fmaxf(mrun, rm);
            const float alpha = __builtin_amdgcn_exp2f(mrun - mn);
            const bool resc = __any(mn > mrun);
            mrun = mn;
            float sacc = 0.f;
#pragma unroll
            for (int r = 0; r < 16; ++r) { p0[r] = __builtin_amdgcn_exp2f(p0[r] - mn); p1[r] = __builtin_amdgcn_exp2f(p1[r] - mn); sacc += p0[r] + p1[r]; }
            l_reg = l_reg * alpha + sacc;
            if (resc) {
                if (hi == 0) wsf[r32] = alpha;
                asm volatile("s_waitcnt lgkmcnt(0)" ::: "memory");
#pragma unroll
                for (int r = 0; r < 16; ++r) { const float f = wsf[crow(r, hi)]; o[0][r] *= f; o[1][r] *= f; }
                asm volatile("s_waitcnt lgkmcnt(0)" ::: "memory");
            }
            u32x4 pw0, pw1, pw2, pw3;
            pw0 = (u32x4){cvt_pk_bf16(p0[0], p0[1]), cvt_pk_bf16(p0[2], p0[3]), cvt_pk_bf16(p0[4], p0[5]), cvt_pk_bf16(p0[6], p0[7])};
            pw1 = (u32x4){cvt_pk_bf16(p0[8], p0[9]), cvt_pk_bf16(p0[10], p0[11]), cvt_pk_bf16(p0[12], p0[13]), cvt_pk_bf16(p0[14], p0[15])};
            pw2 = (u32x4){cvt_pk_bf16(p1[0], p1[1]), cvt_pk_bf16(p1[2], p1[3]), cvt_pk_bf16(p1[4], p1[5]), cvt_pk_bf16(p1[6], p1[7])};
            pw3 = (u32x4){cvt_pk_bf16(p1[8], p1[9]), cvt_pk_bf16(p1[10], p1[11]), cvt_pk_bf16(p1[12], p1[13]), cvt_pk_bf16(p1[14], p1[15])};
            __builtin_amdgcn_sched_barrier(0);
            pv(o, vb0 + slot, __builtin_bit_cast(bf16x8, pw0), __builtin_bit_cast(bf16x8, pw1), __builtin_bit_cast(bf16x8, pw2), __builtin_bit_cast(bf16x8, pw3));
        }
        slot = (slot == (NSLOT - 1) * SLOTB) ? 0 : slot + SLOTB;
    }
    { auto rr = __builtin_amdgcn_permlane32_swap(__float_as_uint(l_reg), __float_as_uint(l_reg), false, false); l_reg = __uint_as_float(rr[0]) + __uint_as_float(rr[1]); }
    if (hi == 0) wsf[32 + r32] = l_reg;
    asm volatile("s_waitcnt lgkmcnt(0)" ::: "memory");
    float rli[16];
#pragma unroll
    for (int r = 0; r < 16; ++r) rli[r] = 1.0f / wsf[32 + crow(r, hi)];
    bf16_t* Ow = O + qrow0 * 512 + head * 64;
    { bf16_t* stg = (bf16_t*)(shm + LDS_OST) + wid * 2048;
#pragma unroll
        for (int r = 0; r < 16; ++r) { const int orow = crow(r, hi);
#pragma unroll
            for (int d0 = 0; d0 < 2; ++d0) stg[orow * 64 + d0 * 32 + r32] = (bf16_t)f2bf(o[d0][r] * rli[r]); }
        asm volatile("s_waitcnt lgkmcnt(0)" ::: "memory");
#pragma unroll
        for (int i = 0; i < 4; ++i) { const int row = i * 8 + (lane >> 3), ch = lane & 7; const u32x4 v = *(const u32x4*)(stg + row * 64 + ch * 8); *(u32x4*)(Ow + (size_t)row * 512 + ch * 8) = v; } }
    asm volatile("s_waitcnt vmcnt(0) lgkmcnt(0)\n\ts_barrier" ::: "memory");
#undef ATT_DMA
}
#undef ATT_WAIT_BAR
}

__device__ __forceinline__ void p3_attn_conv(const Args& a, char* lds_generic, int tid) {
    const bf16_t* U = (const bf16_t*)(a.ws + WS_U); const bf16_t* KVC = (const bf16_t*)(a.ws + WS_KVC);
    bf16_t* O = (bf16_t*)((unsigned char*)a.out + DO_O); bf16_t* A1 = (bf16_t*)((unsigned char*)a.out + DO_A1);
    const int G = gridDim.x;
    constexpr int NU = NBATCH * 2 * 16 * 2;
    const int per = (NU + G - 1) / G;
    for (int i = 0; i < per; ++i) { const int id = blockIdx.x * per + i; if (id >= NU) break;
        const int hp = id & 1, qb = (id >> 1) & 15, kvh = (id >> 5) & 1, b = id >> 6;
        att::attn_unit(b, kvh, qb, hp, U, KVC, O, a.sink, lds_generic); }
    for (int task = blockIdx.x * 512 + tid; task < (MLAT / 8) * 64; task += G * 512) {
        const int cch = task & 63, rg = task >> 6, c0 = 8 * cch, t0 = 8 * rg;
        float w0[8], w1[8], w2[8], bc[8];
#pragma unroll
        for (int q = 0; q < 2; ++q) { const f32x4 x0 = *(const f32x4*)(a.w_conv + c0 + 4 * q), x1 = *(const f32x4*)(a.w_conv + 512 + c0 + 4 * q), x2 = *(const f32x4*)(a.w_conv + 1024 + c0 + 4 * q), xb = *(const f32x4*)(a.b_conv + c0 + 4 * q);
#pragma unroll
            for (int e = 0; e < 4; ++e) { w0[4 * q + e] = x0[e]; w1[4 * q + e] = x1[e]; w2[4 * q + e] = x2[e]; bc[4 * q + e] = xb[e]; } }
        float up[8], uc[8], un[8];
        const int tl = t0 & (SEQ - 1);
#define CONV_LOADU(dst, t, valid) do { if (valid) { const u32x4 cg_ = *(const u32x4*)(U + (size_t)(t) * NIN + C_CG + c0), xi_ = *(const u32x4*)(U + (size_t)(t) * NIN + C_X + c0); \
            _Pragma("unroll") for (int e = 0; e < 4; ++e) { dst[2 * e] = bflo(cg_[e]) * bflo(xi_[e]); dst[2 * e + 1] = bfhi(cg_[e]) * bfhi(xi_[e]); } } \
            else { _Pragma("unroll") for (int e = 0; e < 8; ++e) dst[e] = 0.f; } } while (0)
        CONV_LOADU(up, t0 - 1, tl > 0);
        CONV_LOADU(uc, t0, true);
#pragma unroll
        for (int r = 0; r < 8; ++r) {
            const int t = t0 + r;
            CONV_LOADU(un, t + 1, (tl + r + 1) < SEQ);
            const u32x4 bb = *(const u32x4*)(U + (size_t)t * NIN + C_B + c0);
            float y[8];
#pragma unroll
            for (int e = 0; e < 8; ++e) y[e] = bc[e] + w0[e] * up[e] + w1[e] * uc[e] + w2[e] * un[e];
            u32x4 w;
#pragma unroll
            for (int e = 0; e < 4; ++e) w[e] = pk2(bflo(bb[e]) * y[2 * e], bfhi(bb[e]) * y[2 * e + 1]);
            *(u32x4*)(A1 + (size_t)t * 512 + c0) = w;
#pragma unroll
            for (int e = 0; e < 8; ++e) { up[e] = uc[e]; uc[e] = un[e]; }
        }
#undef CONV_LOADU
    }
}

struct SchedZ {
    int G, c; const char* A0; const char* A1; const char* B0; const char* B1;
    __device__ __forceinline__ bool next(int i, pg8::Unit& u) const {
        const long L = (long)(i >> 1) * G + c; if (L >= 256) return false;
        pg8::static_map(64, 4, (int)L, u.pm, u.pn); u.aux = i & 1; return true;
    }
    __device__ __forceinline__ const char* abase(const pg8::Unit& u) const { return (u.aux ? A1 : A0) + (size_t)u.pm * (256 * 512 * 2); }
    __device__ __forceinline__ const char* bbase(const pg8::Unit& u) const { return (u.aux ? B1 : B0) + (size_t)u.pn * (256 * 512 * 2); }
    __device__ __forceinline__ int arow(const pg8::Unit&, int) const { return 0; }
};
struct EpiZ {
    static constexpr bool PERM = true;
    const bf16_t* U; bf16_t* Z;
    __device__ __forceinline__ bool operator()(pg8::Acc& acc, const pg8::Unit& u, int wr, int wc, int fr, int fq) const {
        const int row0 = u.pm * 256 + wr * 64 + fr, col0 = u.pn * 256 + wc * 32 + 8 * fq;
#pragma unroll
        for (int ai = 0; ai < 2; ++ai)
#pragma unroll
            for (int m = 0; m < 4; ++m) { const int row = row0 + ai * 128 + m * 16;
#pragma unroll
                for (int bj = 0; bj < 2; ++bj) { const int c = col0 + bj * 128;
                    const u32x4 gbw = *(const u32x4*)(U + (size_t)row * NIN + C_GB + c);
                    f32x4 v0 = acc[ai][bj][m][0], v1 = acc[ai][bj][m][1];
                    if (u.aux == 0) {
                        const u32x4 gaw = *(const u32x4*)(U + (size_t)row * NIN + C_GA + c);
#pragma unroll
                        for (int e = 0; e < 2; ++e) { v0[2 * e] *= (1.0f + enegf_(bflo(gbw[e]))) * sigmoidf_(bflo(gaw[e])); v0[2 * e + 1] *= (1.0f + enegf_(bfhi(gbw[e]))) * sigmoidf_(bfhi(gaw[e]));
                            v1[2 * e] *= (1.0f + enegf_(bflo(gbw[2 + e]))) * sigmoidf_(bflo(gaw[2 + e])); v1[2 * e + 1] *= (1.0f + enegf_(bfhi(gbw[2 + e]))) * sigmoidf_(bfhi(gaw[2 + e])); }
                        acc[ai][bj][m][0] = v0; acc[ai][bj][m][1] = v1;
                    } else {
#pragma unroll
                        for (int e = 0; e < 2; ++e) { v0[2 * e] *= sigmoidf_(bflo(gbw[e])); v0[2 * e + 1] *= sigmoidf_(bfhi(gbw[e])); v1[2 * e] *= sigmoidf_(bflo(gbw[2 + e])); v1[2 * e + 1] *= sigmoidf_(bfhi(gbw[2 + e])); }
                        u32x4 w; w.x = cvt_pk_bf16(v0[0], v0[1]); w.y = cvt_pk_bf16(v0[2], v0[3]); w.z = cvt_pk_bf16(v1[0], v1[1]); w.w = cvt_pk_bf16(v1[2], v1[3]);
                        *(u32x4*)(Z + (size_t)row * DM + c) = w;
                    }
                } }
        return u.aux == 0;
    }
};

struct SchedDense {
    int G, c, nM, nN; const char* A; const char* Bt; size_t tstep;
    __device__ __forceinline__ bool next(int i, pg8::Unit& u) const { const long L = (long)i * G + c; if (L >= (long)nM * nN) return false; pg8::static_map(nM, nN, (int)L, u.pm, u.pn); u.aux = 0; return true; }
    __device__ __forceinline__ const char* abase(const pg8::Unit& u) const { return A + (size_t)u.pm * tstep; }
    __device__ __forceinline__ const char* bbase(const pg8::Unit& u) const { return Bt + (size_t)u.pn * tstep; }
    __device__ __forceinline__ int arow(const pg8::Unit&, int) const { return 0; }
};
struct EpiX1 {
    static constexpr bool PERM = false;
    const float* x; const float* mod; float* X1;
    __device__ __forceinline__ bool operator()(pg8::Acc& acc, const pg8::Unit& u, int wr, int wc, int fr, int fq) const {
        const int row0 = u.pm * 256 + wr * 64 + fr, col0 = u.pn * 256 + wc * 32 + 4 * fq; const int b = (u.pm * 256) >> 11;
        f32x4 g[2][2];
#pragma unroll
        for (int bj = 0; bj < 2; ++bj)
#pragma unroll
            for (int n = 0; n < 2; ++n) g[bj][n] = *(const f32x4*)(mod + b * 6144 + 2048 + col0 + bj * 128 + n * 16);
#pragma unroll
        for (int ai = 0; ai < 2; ++ai)
#pragma unroll
            for (int m = 0; m < 4; ++m) { const size_t off = (size_t)(row0 + ai * 128 + m * 16) * DM + col0;
#pragma unroll
                for (int bj = 0; bj < 2; ++bj)
#pragma unroll
                    for (int n = 0; n < 2; ++n) { const f32x4 xv = *(const f32x4*)(x + off + bj * 128 + n * 16); *(f32x4*)(X1 + off + bj * 128 + n * 16) = xv + g[bj][n] * acc[ai][bj][m][n]; }
                if (m & 1) asm volatile("" ::: "memory"); }
        return false;
    }
};

__device__ __forceinline__ void p5_norm2_route(const Args& a, LAS unsigned char* lds, int tid, int lane, int wave) {
    const float* mod = (const float*)(a.ws + WS_MOD); const float* X1 = a.out;
    bf16_t* H2 = (bf16_t*)(a.ws + WS_H2);
    const bf16_t* wrh = (const bf16_t*)(a.ws + WS_WR); const bf16_t* wrl = wrh + 48 * 1024;
    unsigned* gcnt = (unsigned*)(a.ws + WS_CTL) + CW_CNT; i32x2* list = (i32x2*)(a.ws + WS_LIST);
    LAS float* part = (LAS float*)lds;
    LAS float* logit = (LAS float*)(lds + 98304);
    LAS float* rinv = (LAS float*)(lds + 98304 + 12288);
    LAS int* hist = (LAS int*)(lds + 98304 + 12288 + 256); LAS int* hbase = hist + 32;
    const int G = gridDim.x, fr = lane & 15, fq = lane >> 4;
    bf16x8 bh[3][4], bl[3][4];
#pragma unroll
    for (int n = 0; n < 3; ++n)
#pragma unroll
        for (int ks = 0; ks < 4; ++ks) { const size_t o = (size_t)(16 * n + fr) * DM + 128 * wave + 32 * ks + 8 * fq; bh[n][ks] = *(const bf16x8*)(wrh + o); bl[n][ks] = *(const bf16x8*)(wrl + o); }
    for (int chunk = blockIdx.x; chunk < MLAT / 64; chunk += G) {
        const int rowb = chunk * 64, b = rowb >> 11;
        if (tid < 32) hist[tid] = 0;
#pragma unroll
        for (int h = 0; h < 2; ++h) {
            f32x4 v[4][4];
#pragma unroll
            for (int r = 0; r < 4; ++r)
#pragma unroll
                for (int j = 0; j < 4; ++j) v[r][j] = *(const f32x4*)(X1 + (size_t)(rowb + 8 * wave + 4 * h + r) * DM + 4 * lane + 256 * j);
#pragma unroll
            for (int r = 0; r < 4; ++r) { float s = 0.f;
#pragma unroll
                for (int j = 0; j < 4; ++j) s += (v[r][j].x * v[r][j].x + v[r][j].y * v[r][j].y) + (v[r][j].z * v[r][j].z + v[r][j].w * v[r][j].w);
                s = wave_sum(s); if (lane == 0) rinv[8 * wave + 4 * h + r] = 1.0f / sqrtf(s * (1.0f / DM) + NORM_EPS); }
        }
        LDS_WAIT(); __syncthreads();
        f32x4 acc[4][3];
#pragma unroll
        for (int mt = 0; mt < 4; ++mt)
#pragma unroll
            for (int n = 0; n < 3; ++n) acc[mt][n] = (f32x4){0.f, 0.f, 0.f, 0.f};
#pragma unroll
        for (int ks = 0; ks < 4; ++ks) {
            const int k0 = 128 * wave + 32 * ks + 8 * fq;
            f32x4 A0, A1, B0, B1;
            { const f32x4 g0 = *(const f32x4*)(a.norm2_g + k0), g1 = *(const f32x4*)(a.norm2_g + k0 + 4), s0 = *(const f32x4*)(mod + b * 6144 + 4096 + k0), s1 = *(const f32x4*)(mod + b * 6144 + 4096 + k0 + 4);
              A0 = g0 * (1.0f + s0); A1 = g1 * (1.0f + s1); B0 = *(const f32x4*)(mod + b * 6144 + 3072 + k0); B1 = *(const f32x4*)(mod + b * 6144 + 3072 + k0 + 4); }
#pragma unroll
            for (int mt = 0; mt < 4; ++mt) {
                const int row = rowb + 16 * mt + fr; const float inv = rinv[16 * mt + fr];
                const f32x4 x0 = *(const f32x4*)(X1 + (size_t)row * DM + k0), x1v = *(const f32x4*)(X1 + (size_t)row * DM + k0 + 4);
                const f32x4 h0 = (x0 * inv) * A0 + B0, h1 = (x1v * inv) * A1 + B1;
                unsigned hb[8]; float rem[8];
#pragma unroll
                for (int e = 0; e < 4; ++e) { hb[e] = f2bf(h0[e]); rem[e] = h0[e] - bf2f((unsigned short)hb[e]); hb[4 + e] = f2bf(h1[e]); rem[4 + e] = h1[e] - bf2f((unsigned short)hb[4 + e]); }
                u32x4 wh, wl;
#pragma unroll
                for (int e = 0; e < 4; ++e) { wh[e] = hb[2 * e] | (hb[2 * e + 1] << 16); wl[e] = pk2(rem[2 * e], rem[2 * e + 1]); }
                *(u32x4*)(H2 + (size_t)row * DM + k0) = wh;
                const bf16x8 ah = __builtin_bit_cast(bf16x8, wh), al = __builtin_bit_cast(bf16x8, wl);
#pragma unroll
                for (int n = 0; n < 3; ++n) {
                    acc[mt][n] = __builtin_amdgcn_mfma_f32_16x16x32_bf16(ah, bh[n][ks], acc[mt][n], 0, 0, 0);
                    acc[mt][n] = __builtin_amdgcn_mfma_f32_16x16x32_bf16(al, bh[n][ks], acc[mt][n], 0, 0, 0);
                    acc[mt][n] = __builtin_amdgcn_mfma_f32_16x16x32_bf16(ah, bl[n][ks], acc[mt][n], 0, 0, 0); }
            }
        }
#pragma unroll
        for (int mt = 0; mt < 4; ++mt)
#pragma unroll
            for (int n = 0; n < 3; ++n)
#pragma unroll
                for (int rg = 0; rg < 4; ++rg) part[(wave * 64 + 16 * mt + 4 * fq + rg) * 48 + 16 * n + fr] = acc[mt][n][rg];
        LDS_WAIT(); __syncthreads();
        for (int idx = tid; idx < 64 * 48; idx += 512) { float sm = part[idx];
#pragma unroll
            for (int w = 1; w < 8; ++w) sm += part[w * 64 * 48 + idx];
            logit[idx] = sm; }
        LDS_WAIT(); __syncthreads();
        int e0 = 0, e1 = 0, rk0 = 0, rk1 = 0; float gt0 = 0.f, gt1 = 0.f;
        if (tid < 64) {
            const LAS float* lg = logit + tid * 48;
            float gm = lg[0] + a.b_group[0]; int gi = 0; float gl[4]; gl[0] = gm;
#pragma unroll
            for (int q = 1; q < 4; ++q) { gl[q] = lg[q] + a.b_group[q]; if (gl[q] > gm) { gm = gl[q]; gi = q; } }
            float gs = 0.f;
#pragma unroll
            for (int q = 0; q < 4; ++q) gs += __expf(gl[q] - gm);
            const float pg = 1.0f / gs;
            float m0 = -INFINITY, m1 = -INFINITY; int i0 = 0, i1 = 0;
            for (int q = 0; q < 8; ++q) { const float v = lg[4 + 8 * gi + q] + a.b_router[8 * gi + q];
                if (v > m0) { m1 = m0; i1 = i0; m0 = v; i0 = q; } else if (v > m1) { m1 = v; i1 = q; } }
            const float rr = __expf(m1 - m0), w0 = 1.0f / (1.0f + rr);
            gt0 = pg * w0; gt1 = pg * (rr * w0); e0 = 8 * gi + i0; e1 = 8 * gi + i1;
            rk0 = __hip_atomic_fetch_add((int*)(hist + e0), 1, __ATOMIC_RELAXED, __HIP_MEMORY_SCOPE_WORKGROUP);
            rk1 = __hip_atomic_fetch_add((int*)(hist + e1), 1, __ATOMIC_RELAXED, __HIP_MEMORY_SCOPE_WORKGROUP);
        }
        LDS_WAIT(); __syncthreads();
        if (tid < 32) { const int n = hist[tid]; hbase[tid] = (n > 0) ? (int)__hip_atomic_fetch_add(gcnt + tid, (unsigned)n, __ATOMIC_RELAXED, __HIP_MEMORY_SCOPE_AGENT) : 0; }
        LDS_WAIT(); __syncthreads();
        if (tid < 64) { const int tok = rowb + tid;
            list[(size_t)e0 * LISTCAP + hbase[e0] + rk0] = (i32x2){tok * 2, __float_as_int(gt0)};
            list[(size_t)e1 * LISTCAP + hbase[e1] + rk1] = (i32x2){tok * 2 + 1, __float_as_int(gt1)}; }
        __syncthreads();
    }
}

struct SchedMoe {
    int G, c, NPN, total; const LAS int* pref; const LAS int* cnt; const char* A; const char* Bt; size_t a_tstep, b_estride, b_tstep; const i32x2* list;
    __device__ __forceinline__ bool next(int i, pg8::Unit& u) const {
        const long L = (long)i * G + c; if (L >= total) return false;
        const int mt = (int)(L / NPN); u.pn = (int)(L % NPN); u.pm = mt;
        int e = 0;
        for (int q = 1; q < NEXP; ++q) e += (pref[q] <= mt) ? 1 : 0;
        e = __builtin_amdgcn_readfirstlane(e);
        u.aux = e | ((mt - pref[e]) << 8); return true;
    }
    __device__ __forceinline__ const char* abase(const pg8::Unit& u) const { return A + (size_t)u.pm * a_tstep; }
    __device__ __forceinline__ const char* bbase(const pg8::Unit& u) const { return Bt + (size_t)(u.aux & 255) * b_estride + (size_t)u.pn * b_tstep; }
    __device__ __forceinline__ int arow(const pg8::Unit& u, int r) const { const int e = u.aux & 255, idx = (u.aux >> 8) * 256 + r; return (idx < cnt[e]) ? (list[(size_t)e * LISTCAP + idx].x >> 1) : 0; }
};
struct EpiUp {
    static constexpr bool PERM = true;
    bf16_t* ACT;
    __device__ __forceinline__ bool operator()(pg8::Acc& acc, const pg8::Unit& u, int wr, int wc, int fr, int fq) const {
        const int row0 = u.pm * 256 + wr * 64 + fr;
#pragma unroll
        for (int ai = 0; ai < 2; ++ai)
#pragma unroll
            for (int m = 0; m < 4; ++m) { bf16_t* rowp = ACT + (size_t)(row0 + ai * 128 + m * 16) * EFF + 128 * u.pn + 16 * wc + 4 * fq;
#pragma unroll
                for (int bj = 0; bj < 2; ++bj) { const f32x4 av = acc[ai][bj][m][0], uv = acc[ai][bj][m][1]; float y[4];
#pragma unroll
                    for (int e = 0; e < 4; ++e) y[e] = av[e] * sigmoidf_(av[e]) * uv[e];
                    u32x2 w; w.x = cvt_pk_bf16(y[0], y[1]); w.y = cvt_pk_bf16(y[2], y[3]); *(u32x2*)(rowp + 64 * bj) = w; } }
        return false;
    }
};
struct EpiDown {
    static constexpr bool PERM = true;
    bf16_t* Y0; bf16_t* dump; const i32x2* list; const LAS int* cnt;
    __device__ __forceinline__ bool operator()(pg8::Acc& acc, const pg8::Unit& u, int wr, int wc, int fr, int fq) const {
        const int e = u.aux & 255, lt = u.aux >> 8, n = cnt[e]; const int col0 = u.pn * 256 + wc * 32 + 8 * fq;
        const i32x2* lp = list + (size_t)e * LISTCAP + lt * 256 + wr * 64 + fr; const int rem = n - (lt * 256 + wr * 64 + fr);
#pragma unroll
        for (int ai = 0; ai < 2; ++ai)
#pragma unroll
            for (int m = 0; m < 4; ++m) { const int o = ai * 128 + m * 16; const bool ok = o < rem;
                const i32x2 en = lp[ok ? o : 0]; const int gbits = en.y; const float gt = __int_as_float(gbits);
                bf16_t* rowp = ok ? (Y0 + (size_t)(en.x & 1) * ((WS_Y1 - WS_Y0) / 2) + (size_t)(en.x >> 1) * DM + col0) : (dump + col0);
#pragma unroll
                for (int bj = 0; bj < 2; ++bj) { const f32x4 v0 = acc[ai][bj][m][0] * gt, v1 = acc[ai][bj][m][1] * gt;
                    u32x4 w; w.x = cvt_pk_bf16(v0[0], v0[1]); w.y = cvt_pk_bf16(v0[2], v0[3]); w.z = cvt_pk_bf16(v1[0], v1[1]); w.w = cvt_pk_bf16(v1[2], v1[3]); *(u32x4*)(rowp + bj * 128) = w; }
                asm volatile("" ::: "memory"); }
        return false;
    }
};
__device__ __forceinline__ int moe_tables(const Args& a, LAS unsigned char* lds, int tid) {
    LAS int* cnt = (LAS int*)(lds + MISC_OFF + 256); LAS int* pref = cnt + 32;
    unsigned* gcnt = (unsigned*)(a.ws + WS_CTL) + CW_CNT;
    __syncthreads();
    if (tid < 32) cnt[tid] = (int)__hip_atomic_load(gcnt + tid, __ATOMIC_RELAXED, __HIP_MEMORY_SCOPE_AGENT);
    LDS_WAIT(); __syncthreads();
    if (tid == 0) { int s = 0; for (int e = 0; e < NEXP; ++e) { pref[e] = s; s += (cnt[e] + 255) >> 8; } pref[NEXP] = s; }
    LDS_WAIT(); __syncthreads();
    return pref[NEXP];
}

__device__ __forceinline__ void p9_final(const Args& a, int lane, int wave) {
    const float* mod = (const float*)(a.ws + WS_MOD); const bf16_t* Y0 = (const bf16_t*)(a.ws + WS_Y0); const bf16_t* Y1 = (const bf16_t*)(a.ws + WS_Y1);
    const int gw = blockIdx.x * 8 + wave, NGW = gridDim.x * 8;
    const int rpw = (MLAT + NGW - 1) / NGW;
    const int r0 = gw * rpw, r1 = (r0 + rpw < MLAT) ? r0 + rpw : MLAT;
    int curb = -1; f32x4 g2[4], fg[4];
#pragma unroll
    for (int j = 0; j < 4; ++j) { fg[j] = *(const f32x4*)(a.final_g + 4 * lane + 256 * j); g2[j] = fg[j]; }
    for (int m = r0; m < r1; ++m) {
        const int b = m >> 11;
        if (b != curb) { curb = b;
#pragma unroll
            for (int j = 0; j < 4; ++j) g2[j] = *(const f32x4*)(mod + b * 6144 + 5120 + 4 * lane + 256 * j); }
        float* xr = a.out + (size_t)m * DM;
        f32x4 v[4]; float s = 0.f;
#pragma unroll
        for (int j = 0; j < 4; ++j) { const int idx = 4 * lane + 256 * j; const f32x4 xv = *(const f32x4*)(xr + idx);
            const u32x2 y0 = *(const u32x2*)(Y0 + (size_t)m * DM + idx), y1 = *(const u32x2*)(Y1 + (size_t)m * DM + idx);
            f32x4 y; y.x = bflo(y0.x) + bflo(y1.x); y.y = bfhi(y0.x) + bfhi(y1.x); y.z = bflo(y0.y) + bflo(y1.y); y.w = bfhi(y0.y) + bfhi(y1.y);
            v[j] = xv + g2[j] * y; s += (v[j].x * v[j].x + v[j].y * v[j].y) + (v[j].z * v[j].z + v[j].w * v[j].w); }
        const float inv = 1.0f / sqrtf(wave_sum(s) * (1.0f / DM) + NORM_EPS);
#pragma unroll
        for (int j = 0; j < 4; ++j) *(f32x4*)(xr + 4 * lane + 256 * j) = (v[j] * inv) * fg[j];
    }
}

__global__ void __launch_bounds__(512, 2) fwd_kernel(Args args) {
    extern __shared__ __attribute__((aligned(16))) unsigned char lds_raw[];
    LAS unsigned char* lds = (LAS unsigned char*)lds_raw;
    const int tid = threadIdx.x, lane = tid & 63, wave = __builtin_amdgcn_readfirstlane(tid >> 6);
    const int G = gridDim.x;
    unsigned char* ws = args.ws;
    volatile LAS unsigned* MISC = (volatile LAS unsigned*)(lds + MISC_OFF);
    for (int u = tid; u < 256; u += 512) MISC[u] = 0u;
    __syncthreads();
    XcdBarrier bar; bar.bar = (unsigned*)(ws + WS_CTL) + CW_BAR; bar.x = 0; bar.st = nullptr;
    if (MK_N_LAUNCHES == 1) bar = xcd_barrier_post((unsigned*)(ws + WS_CTL) + CW_BAR, MISC + 8);
    const int lo = args.ph_lo, hi = args.ph_hi;
#ifndef PHMASK
#define PHMASK 0x3ff
#endif
#define IN(k) (((PHMASK >> (k)) & 1) && lo <= (k) && (k) < hi)
#define SEAM(k) do { if (IN(k) && IN((k) + 1)) xcd_barrier(bar); } while (0)

    if (IN(0)) { p0_prologue(args, lds, tid, lane, wave); SEAM(0); }
    if (IN(1)) { p1_norm1(args, lane, wave); SEAM(1); }
    if (IN(2)) {
        SchedIn S{G, (int)blockIdx.x, (const char*)args.out + DO_H, (const char*)(ws + WS_WIN)};
        EpiIn E{(bf16_t*)(ws + WS_U), (bf16_t*)(ws + WS_KVC), (const float*)(ws + WS_ROPE), (const float*)(ws + WS_ROPE) + 2048 * 32};
        pg8::gemm_phase<EpiIn, SchedIn, true, false>(lds, 1024, S, E);
        SEAM(2);
    }
    if (IN(3)) { p3_attn_conv(args, (char*)lds_raw, tid); SEAM(3); }
    if (IN(4)) {
        SchedZ S{G, (int)blockIdx.x, (const char*)args.out + DO_A1, (const char*)args.out + DO_O, (const char*)(ws + WS_WA), (const char*)(ws + WS_WB)};
        EpiZ E{(const bf16_t*)(ws + WS_U), (bf16_t*)(ws + WS_Z)};
        pg8::gemm_phase<EpiZ, SchedZ, false, false>(lds, 512, S, E);
        SEAM(4);
    }
    if (IN(5)) {
        SchedDense S{G, (int)blockIdx.x, 64, 4, (const char*)(ws + WS_Z), (const char*)(ws + WS_WO), (size_t)256 * 1024 * 2};
        EpiX1 E{args.x, (const float*)(ws + WS_MOD), args.out};
        pg8::gemm_phase<EpiX1, SchedDense, false, false>(lds, 1024, S, E);
        SEAM(5);
    }
    if (IN(6)) { p5_norm2_route(args, lds, tid, lane, wave); SEAM(6); }
    if (IN(7)) {
        const int T = moe_tables(args, lds, tid);
        SchedMoe S{G, (int)blockIdx.x, 2, 2 * T, (const LAS int*)(lds + MISC_OFF + 256) + 32, (const LAS int*)(lds + MISC_OFF + 256), (const char*)(ws + WS_H2), (const char*)(ws + WS_WUP), 0, (size_t)512 * 1024 * 2, (size_t)256 * 1024 * 2, (const i32x2*)(ws + WS_LIST)};
        EpiUp E{(bf16_t*)(ws + WS_ACT)};
        pg8::gemm_phase<EpiUp, SchedMoe, true, true>(lds, 1024, S, E);
        SEAM(7);
    }
    if (IN(8)) {
        const int T = moe_tables(args, lds, tid);
        SchedMoe S{G, (int)blockIdx.x, 4, 4 * T, (const LAS int*)(lds + MISC_OFF + 256) + 32, (const LAS int*)(lds + MISC_OFF + 256), (const char*)(ws + WS_ACT), (const char*)(ws + WS_WDN), (size_t)256 * 256 * 2, (size_t)1024 * 256 * 2, (size_t)256 * 256 * 2, (const i32x2*)(ws + WS_LIST)};
        EpiDown E{(bf16_t*)(ws + WS_Y0), (bf16_t*)(ws + WS_DUMP) + (size_t)blockIdx.x * 1024, (const i32x2*)(ws + WS_LIST), (const LAS int*)(lds + MISC_OFF + 256)};
        pg8::gemm_phase<EpiDown, SchedMoe, true, false>(lds, 256, S, E);
        SEAM(8);
    }
    if (IN(9)) { p9_final(args, lane, wave); }
#undef IN
#undef SEAM
}

extern "C" void kernel_launch(void* const* d_in, const int* in_sizes, int n_in, void* d_out, int out_size, void* d_ws, size_t ws_size, hipStream_t stream) {
    static int grid = 0;
    if (grid == 0) {
        if (n_in != 22 || out_size != MLAT * DM || ws_size < WS_END) { fprintf(stderr, "kernel_launch: unexpected problem (n_in %d, out %d, ws %zu)\n", n_in, out_size, ws_size); grid = -1; return; }
        int dev = 0, cus = 0, per_cu = 0;
        if (hipGetDevice(&dev) != hipSuccess || hipDeviceGetAttribute(&cus, hipDeviceAttributeMultiprocessorCount, dev) != hipSuccess) { grid = -1; return; }
        if (hipFuncSetAttribute((const void*)fwd_kernel, hipFuncAttributeMaxDynamicSharedMemorySize, LDS_BYTES) != hipSuccess) { fprintf(stderr, "kernel_launch: hipFuncSetAttribute failed\n"); grid = -1; return; }
        if (hipOccupancyMaxActiveBlocksPerMultiprocessor(&per_cu, (const void*)fwd_kernel, 512, LDS_BYTES) != hipSuccess || per_cu < 1) { fprintf(stderr, "kernel_launch: occupancy query says %d\n", per_cu); (void)hipGetLastError(); per_cu = 1; }
        grid = cus;
        if (grid > 256) grid = 256;
    }
    if (grid < 0) return;
    (void)hipMemsetAsync((char*)d_ws + WS_CTL, 0, CTL_ZERO_BYTES, stream);
    Args a{};
    const float** p = (const float**)&a;
    for (int i = 0; i < 22; ++i) p[i] = (const float*)d_in[i];
    a.out = (float*)d_out; a.ws = (unsigned char*)d_ws;
#if MK_N_LAUNCHES == 1
    a.ph_lo = 0; a.ph_hi = NPHASE;
    void* kargs[] = {&a};
    hipError_t e = hipLaunchCooperativeKernel((const void*)fwd_kernel, dim3(grid), dim3(512), kargs, LDS_BYTES, stream);
    if (e != hipSuccess) fprintf(stderr, "cooperative launch failed: %s (grid %d)\n", hipGetErrorString(e), grid);
#else
    for (int ph = 0; ph < NPHASE; ++ph) { a.ph_lo = ph; a.ph_hi = ph + 1; hipLaunchKernelGGL(fwd_kernel, dim3(grid), dim3(512), LDS_BYTES, stream, a); }
#endif
}
```
